# Optimizing an MI355X kernel written in HIP

```python
import jax, jax.numpy as jnp
from jax import lax
import numpy as np

D_MODEL = 1024
BATCH = 8
SEQ = 2048
DEPTH = 1

MEM_LEN = 256
D_MIX = D_MODEL
D_SGU = D_MIX // 2
SGU_HEADS = 4
SGU_HEAD_DIM = D_SGU // SGU_HEADS
CHUNK = 128
D_RWKV = D_MIX - D_SGU
RWKV_HEAD_DIM = 64
RWKV_HEADS = D_RWKV // RWKV_HEAD_DIM
DECAY_LORA = 64
ICL_LORA = 64
C_SGU = 3 * D_SGU
C_RWKV = 4 * D_RWKV + DECAY_LORA + ICL_LORA
C_IN = C_SGU + C_RWKV
XATTN_HEADS = 4
XATTN_HEAD_DIM = D_MODEL // XATTN_HEADS
RMS_EPS = 1e-6
LN_EPS = 1e-5
GN_EPS = 64e-5

kernel_name = 'hybrid_sgu_rwkv7_memxattn'


def rms_norm(x, g):
    xf = x.astype(jnp.float32)
    y = xf * lax.rsqrt(jnp.mean(xf * xf, axis=-1, keepdims=True) + RMS_EPS)
    return (y * g.astype(jnp.float32)).astype(x.dtype)


def layer_norm(x, g, b):
    xf = x.astype(jnp.float32)
    mu = jnp.mean(xf, axis=-1, keepdims=True)
    var = jnp.mean(jnp.square(xf - mu), axis=-1, keepdims=True)
    y = (xf - mu) * lax.rsqrt(var + LN_EPS)
    return (y * g.astype(jnp.float32) + b.astype(jnp.float32)).astype(x.dtype)


def token_shift(z):
    return jnp.pad(z, ((0, 0), (1, 0), (0, 0)))[:, :-1]


def sgu_group(z, ln_g, ln_b, ws, bs, out_g):
    b, s, _ = z.shape
    u, v, gate = jnp.split(z, 3, axis=-1)
    u = jax.nn.gelu(u, approximate=False)
    v = layer_norm(jax.nn.gelu(v, approximate=False), ln_g, ln_b)
    v = v.reshape(b, s // CHUNK, CHUNK, SGU_HEADS, SGU_HEAD_DIM)
    causal = jnp.tril(jnp.ones((CHUNK, CHUNK), dtype=bool))
    ws_c = jnp.where(causal[None], ws, jnp.zeros_like(ws))
    sv = jnp.einsum('hts,bcshd->bcthd', ws_c, v) + jnp.swapaxes(bs, 0, 1)[None, None, :, :, None]
    y = rms_norm(u * sv.reshape(b, s, D_SGU), out_g)
    return y * jax.nn.silu(gate)


def rwkv7_step(state, inp):
    r, w, k, v, a, bb = inp
    sa = jnp.einsum('bhvk,bhk->bhv', state, a)
    state = state * w[:, :, None, :] + sa[..., None] * bb[:, :, None, :] + v[..., None] * k[:, :, None, :]
    y = jnp.einsum('bhvk,bhk->bhv', state, r)
    return state, y


def rwkv7_group(z, mu, w0, w2, a0, a2, k_k, k_a, r_k, gn_g, gn_b):
    b, s, _ = z.shape
    z = z + (token_shift(z) - z) * mu
    r, k, v, gate, wd, ad = jnp.split(
        z, [D_RWKV, 2 * D_RWKV, 3 * D_RWKV, 4 * D_RWKV, 4 * D_RWKV + DECAY_LORA], axis=-1)
    logw = -jax.nn.softplus(-(w0 + jnp.tanh(wd) @ w2)) - 0.5
    decay = jnp.exp(-jnp.exp(logw.astype(jnp.float32)))
    icl = jax.nn.sigmoid(a0 + ad @ a2)
    heads = lambda t: t.astype(jnp.float32).reshape(b, s, RWKV_HEADS, RWKV_HEAD_DIM)
    kk = heads(k * k_k)
    kk = kk * lax.rsqrt(jnp.maximum(jnp.sum(kk * kk, axis=-1, keepdims=True), 1e-24))
    k = k * (1 + (icl - 1) * k_a)
    rh, wh, kh, vh, ah = heads(r), heads(decay), heads(k), heads(v), heads(icl)
    seq_major = lambda t: jnp.moveaxis(t, 1, 0)
    state0 = jnp.zeros((b, RWKV_HEADS, RWKV_HEAD_DIM, RWKV_HEAD_DIM), jnp.float32)
    _, y = lax.scan(rwkv7_step, state0,
                    (seq_major(rh), seq_major(wh), seq_major(kh), seq_major(vh),
                     seq_major(-kk), seq_major(kk * ah)))
    y = jnp.moveaxis(y, 0, 1)
    mean = jnp.mean(y, axis=-1, keepdims=True)
    var = jnp.mean(jnp.square(y - mean), axis=-1, keepdims=True)
    yn = ((y - mean) * lax.rsqrt(var + GN_EPS)).reshape(b, s, D_RWKV)
    yn = yn * gn_g.astype(jnp.float32) + gn_b.astype(jnp.float32)
    bonus = jnp.sum(rh * kh * r_k.astype(jnp.float32), axis=-1, keepdims=True) * vh
    out = (yn + bonus.reshape(b, s, D_RWKV)).astype(z.dtype)
    return out * jax.nn.silu(gate)


def mem_cross_attention(h, mem, g_x, g_mem, w_q, w_kv, w_o):
    b, s, _ = h.shape
    m = mem.shape[1]
    hn = rms_norm(h, g_x)
    mn = rms_norm(mem, g_mem)
    q = (hn @ w_q).reshape(b, s, XATTN_HEADS, XATTN_HEAD_DIM)
    k, v = jnp.split(mn @ w_kv, 2, axis=-1)
    k = k.reshape(b, m, XATTN_HEADS, XATTN_HEAD_DIM)
    v = v.reshape(b, m, XATTN_HEADS, XATTN_HEAD_DIM)
    scores = jnp.einsum('bqhd,bkhd->bhqk', q, k).astype(jnp.float32) * (XATTN_HEAD_DIM ** -0.5)
    p = jax.nn.softmax(scores, axis=-1).astype(v.dtype)
    o = jnp.einsum('bhqk,bkhd->bqhd', p, v).reshape(b, s, D_MODEL)
    return o @ w_o


def setup_inputs(seed: int = 0) -> dict:
    key = jax.random.key(seed)
    ks = jax.random.split(key, 26)
    L = DEPTH
    nrm = lambda k, shape, scale: scale * jax.random.normal(k, shape, jnp.float32)
    gain = lambda k, shape: 1.0 + 0.01 * jax.random.normal(k, shape, jnp.float32)
    return {
        'x': nrm(ks[0], (BATCH, SEQ, D_MODEL), 1.0),
        'mem': nrm(ks[1], (BATCH, MEM_LEN, D_MODEL), 1.0),
        'ln_mix_g': gain(ks[2], (L, D_MODEL)),
        'w_in': nrm(ks[3], (L, D_MODEL, C_IN), D_MODEL ** -0.5),
        'sgu_ln_g': gain(ks[4], (L, D_SGU)),
        'sgu_ln_b': nrm(ks[5], (L, D_SGU), 0.01),
        'sgu_ws': nrm(ks[6], (L, SGU_HEADS, CHUNK, CHUNK), CHUNK ** -0.5),
        'sgu_bs': gain(ks[7], (L, SGU_HEADS, CHUNK)),
        'sgu_out_g': gain(ks[8], (L, D_SGU)),
        'rw_mu': jax.random.uniform(ks[9], (L, C_RWKV), jnp.float32),
        'rw_w0': jax.random.uniform(ks[10], (L, D_RWKV), jnp.float32, -4.0, 0.0),
        'rw_w2': nrm(ks[11], (L, DECAY_LORA, D_RWKV), 0.1),
        'rw_a0': nrm(ks[12], (L, D_RWKV), 0.1),
        'rw_a2': nrm(ks[13], (L, ICL_LORA, D_RWKV), 0.1),
        'rw_k_k': 0.85 + 0.01 * jax.random.normal(ks[14], (L, D_RWKV), jnp.float32),
        'rw_k_a': gain(ks[15], (L, D_RWKV)),
        'rw_r_k': nrm(ks[16], (L, RWKV_HEADS, RWKV_HEAD_DIM), 0.1),
        'rw_gn_g': gain(ks[17], (L, D_RWKV)),
        'rw_gn_b': nrm(ks[18], (L, D_RWKV), 0.01),
        'w_out': nrm(ks[19], (L, D_MIX, D_MODEL), D_MIX ** -0.5),
        'ln_x_g': gain(ks[20], (L, D_MODEL)),
        'ln_mem_g': gain(ks[21], (L, D_MODEL)),
        'w_q': nrm(ks[22], (L, D_MODEL, D_MODEL), D_MODEL ** -0.5),
        'w_kv': nrm(ks[23], (L, D_MODEL, 2 * D_MODEL), D_MODEL ** -0.5),
        'w_o': nrm(ks[24], (L, D_MODEL, D_MODEL), D_MODEL ** -0.5),
        'ln_f_g': gain(ks[25], (D_MODEL,)),
    }


def reference(x, mem, ln_mix_g, w_in, sgu_ln_g, sgu_ln_b, sgu_ws, sgu_bs, sgu_out_g,
              rw_mu, rw_w0, rw_w2, rw_a0, rw_a2, rw_k_k, rw_k_a, rw_r_k, rw_gn_g, rw_gn_b,
              w_out, ln_x_g, ln_mem_g, w_q, w_kv, w_o, ln_f_g):
    h = x
    for l in range(DEPTH):
        z = rms_norm(h, ln_mix_g[l]) @ w_in[l]
        y_sgu = sgu_group(z[..., :C_SGU], sgu_ln_g[l], sgu_ln_b[l], sgu_ws[l], sgu_bs[l], sgu_out_g[l])
        y_rwkv = rwkv7_group(z[..., C_SGU:], rw_mu[l], rw_w0[l], rw_w2[l], rw_a0[l], rw_a2[l],
                             rw_k_k[l], rw_k_a[l], rw_r_k[l], rw_gn_g[l], rw_gn_b[l])
        h = h + jnp.concatenate([y_sgu, y_rwkv], axis=-1) @ w_out[l]
        h = h + mem_cross_attention(h, mem, ln_x_g[l], ln_mem_g[l], w_q[l], w_kv[l], w_o[l])
    return rms_norm(h, ln_f_g)
```

```cpp
#include <hip/hip_runtime.h>
#include <cstdio>
#include <cstdint>

namespace {
constexpr int NB = 8, SEQ = 2048, DM = 1024, M = NB * SEQ, MEML = 256, MM = NB * MEML;
constexpr int DSGU = 512, DRW = 512, CSGU = 1536, CRW = 2176, CIN = 3712, CH = 128;
constexpr float RMS_EPS = 1e-6f, LN_EPS = 1e-5f, GN_EPS = 64e-5f;
typedef unsigned short bf16;
constexpr size_t MiB = 1u << 20;

__device__ __forceinline__ bf16 f2bf(float f) { unsigned u = __float_as_uint(f); return (bf16)((u + 0x7fffu + ((u >> 16) & 1u)) >> 16); }
__device__ __forceinline__ float bf2f(bf16 h) { return __uint_as_float(((unsigned)h) << 16); }
__device__ __forceinline__ float wave_sum(float v) {
#pragma unroll
    for (int o = 1; o < 64; o <<= 1) v += __shfl_xor(v, o);
    return v;
}
__device__ __forceinline__ float wave_max(float v) {
#pragma unroll
    for (int o = 1; o < 64; o <<= 1) v = fmaxf(v, __shfl_xor(v, o));
    return v;
}
__device__ __forceinline__ float gelu_exact(float x) { return 0.5f * x * (1.f + erff(x * 0.70710678118654752f)); }
__device__ __forceinline__ float silu(float x) { return x / (1.f + __expf(-x)); }
__device__ __forceinline__ float sigmoidf(float x) { return 1.f / (1.f + __expf(-x)); }

__global__ void k_rmsnorm_rows(const float* x, const float* g, float* out, int rows) {
    const int row = blockIdx.x * 4 + (threadIdx.x >> 6), lane = threadIdx.x & 63;
    if (row >= rows) return;
    const float* xr = x + (size_t)row * DM; float v[16]; float s = 0.f;
#pragma unroll
    for (int j = 0; j < 16; ++j) { v[j] = xr[lane + 64 * j]; s += v[j] * v[j]; }
    s = wave_sum(s); const float rs = rsqrtf(s * (1.f / DM) + RMS_EPS);
#pragma unroll
    for (int j = 0; j < 16; ++j) out[(size_t)row * DM + lane + 64 * j] = v[j] * rs * g[lane + 64 * j];
}

template <int EPI>
__global__ void __launch_bounds__(256) k_gemm(const float* A, const float* Bm, int Mr, int N, int K, float* Cf, bf16* Cb, const float* R) {
    __shared__ float sA[16][68];
    __shared__ float sB[16][68];
    const int tx = threadIdx.x & 15, ty = threadIdx.x >> 4, m0 = blockIdx.y * 64, n0 = blockIdx.x * 64;
    float acc[4][4];
#pragma unroll
    for (int i = 0; i < 4; ++i)
#pragma unroll
        for (int j = 0; j < 4; ++j) acc[i][j] = 0.f;
    for (int k0 = 0; k0 < K; k0 += 16) {
#pragma unroll
        for (int i = 0; i < 4; ++i) {
            const int e = threadIdx.x + 256 * i;
            { const int r = e >> 4, c = e & 15; sA[c][r] = A[(size_t)(m0 + r) * K + k0 + c]; }
            { const int r = e >> 6, c = e & 63; sB[r][c] = Bm[(size_t)(k0 + r) * N + n0 + c]; }
        }
        __syncthreads();
#pragma unroll
        for (int kk = 0; kk < 16; ++kk) {
            float a[4], b[4];
#pragma unroll
            for (int i = 0; i < 4; ++i) { a[i] = sA[kk][ty * 4 + i]; b[i] = sB[kk][tx * 4 + i]; }
#pragma unroll
            for (int i = 0; i < 4; ++i)
#pragma unroll
                for (int j = 0; j < 4; ++j) acc[i][j] += a[i] * b[j];
        }
        __syncthreads();
    }
#pragma unroll
    for (int i = 0; i < 4; ++i)
#pragma unroll
        for (int j = 0; j < 4; ++j) {
            const size_t o = (size_t)(m0 + ty * 4 + i) * N + n0 + tx * 4 + j;
            if (EPI == 0) Cb[o] = f2bf(acc[i][j]);
            else if (EPI == 1) Cf[o] = acc[i][j];
            else Cf[o] = R[o] + acc[i][j];
        }
}

__global__ void k_sgu_ln(const bf16* z, const float* g, const float* b, float* vln) {
    const int tok = blockIdx.x * 4 + (threadIdx.x >> 6), lane = threadIdx.x & 63;
    const bf16* zr = z + (size_t)tok * CIN + 512; float v[8]; float s = 0.f;
#pragma unroll
    for (int j = 0; j < 8; ++j) { v[j] = gelu_exact(bf2f(zr[lane + 64 * j])); s += v[j]; }
    const float mu = wave_sum(s) * (1.f / 512.f); float q = 0.f;
#pragma unroll
    for (int j = 0; j < 8; ++j) { v[j] -= mu; q += v[j] * v[j]; }
    const float rs = rsqrtf(wave_sum(q) * (1.f / 512.f) + LN_EPS);
#pragma unroll
    for (int j = 0; j < 8; ++j) vln[(size_t)tok * 512 + lane + 64 * j] = v[j] * rs * g[lane + 64 * j] + b[lane + 64 * j];
}
__global__ void __launch_bounds__(512) k_sgu_mix(const bf16* z, const float* vln, const float* ws, const float* bs, const float* og, float* ymix) {
    __shared__ float red[8];
    const int tok = blockIdx.x, f = threadIdx.x, h = f >> 7, t = tok & 127, c0 = tok - t;
    const float* wr = ws + ((size_t)h * CH + t) * CH;
    float sv = bs[h * CH + t];
    for (int s = 0; s <= t; ++s) sv += wr[s] * vln[(size_t)(c0 + s) * 512 + f];
    const float u = gelu_exact(bf2f(z[(size_t)tok * CIN + f]));
    const float p = u * sv;
    const float ss = wave_sum(p * p);
    if ((f & 63) == 0) red[f >> 6] = ss;
    __syncthreads();
    float tot = 0.f;
#pragma unroll
    for (int i = 0; i < 8; ++i) tot += red[i];
    const float rs = rsqrtf(tot * (1.f / 512.f) + RMS_EPS);
    const float gate = bf2f(z[(size_t)tok * CIN + 1024 + f]);
    ymix[(size_t)tok * DM + f] = p * rs * og[f] * silu(gate);
}

__device__ __forceinline__ float zmix(const bf16* z, int tok, int j, const float* mu) {
    const float zt = bf2f(z[(size_t)tok * CIN + CSGU + j]);
    const float zp = (tok & (SEQ - 1)) ? bf2f(z[(size_t)(tok - 1) * CIN + CSGU + j]) : 0.f;
    return zt + (zp - zt) * mu[j];
}
__global__ void __launch_bounds__(512) k_rw_prep(const bf16* z, const float* mu, const float* w0, const float* w2, const float* a0, const float* a2,
                                                  const float* k_k, const float* k_a, bf16* R, bf16* Kk, bf16* V, bf16* KK, float* W, float* ICL) {
    __shared__ float swd[64], sad[64];
    const int tok = blockIdx.x, c = threadIdx.x;
    const float r = zmix(z, tok, c, mu), k = zmix(z, tok, 512 + c, mu), v = zmix(z, tok, 1024 + c, mu);
    if (c < 64) swd[c] = tanhf(zmix(z, tok, 2048 + c, mu));
    else if (c < 128) sad[c - 64] = zmix(z, tok, 2112 + (c - 64), mu);
    __syncthreads();
    float lw = w0[c], la = a0[c];
    for (int j = 0; j < 64; ++j) { lw += swd[j] * w2[j * 512 + c]; la += sad[j] * a2[j * 512 + c]; }
    const float xx = -lw;
    const float sp = fmaxf(xx, 0.f) + log1pf(expf(-fabsf(xx)));
    const float logw = -sp - 0.5f;
    const float decay = expf(-expf(logw));
    const float ic = sigmoidf(la);
    float kk = k * k_k[c];
    const float ss = wave_sum(kk * kk);
    kk *= rsqrtf(fmaxf(ss, 1e-24f));
    const float k2 = k * (1.f + (ic - 1.f) * k_a[c]);
    const size_t o = (size_t)tok * 512 + c;
    R[o] = f2bf(r); Kk[o] = f2bf(k2); V[o] = f2bf(v); KK[o] = f2bf(kk); W[o] = decay; ICL[o] = ic;
}
__global__ void __launch_bounds__(64) k_rw_scan(const bf16* R, const bf16* Kk, const bf16* V, const bf16* KK, const float* W, const float* ICL, float* ymix) {
    __shared__ float sr[8][64], sw[8][64], sk[8][64], sa[8][64], sb[8][64], svv[8][64];
    const int bh = blockIdx.x, b = bh >> 3, h = bh & 7, lane = threadIdx.x;
    float S[64];
#pragma unroll
    for (int j = 0; j < 64; ++j) S[j] = 0.f;
    for (int t0 = 0; t0 < SEQ; t0 += 8) {
        __syncthreads();
#pragma unroll
        for (int i = 0; i < 8; ++i) {
            const size_t o = (size_t)(b * SEQ + t0 + i) * 512 + h * 64 + lane;
            const float kk = bf2f(KK[o]);
            sr[i][lane] = bf2f(R[o]); sw[i][lane] = W[o]; sk[i][lane] = bf2f(Kk[o]); sa[i][lane] = -kk; sb[i][lane] = kk * ICL[o]; svv[i][lane] = bf2f(V[o]);
        }
        __syncthreads();
        for (int i = 0; i < 8; ++i) {
            float dot = 0.f;
#pragma unroll
            for (int j = 0; j < 64; ++j) dot += S[j] * sa[i][j];
            const float vv = svv[i][lane];
            float y = 0.f;
#pragma unroll
            for (int j = 0; j < 64; ++j) { S[j] = S[j] * sw[i][j] + dot * sb[i][j] + vv * sk[i][j]; y += S[j] * sr[i][j]; }
            ymix[(size_t)(b * SEQ + t0 + i) * DM + 512 + h * 64 + lane] = y;
        }
    }
}
__global__ void k_rw_post(const bf16* z, const float* mu, const bf16* R, const bf16* Kk, const bf16* V, const float* r_k, const float* gn_g, const float* gn_b, float* ymix) {
    const int gw = blockIdx.x * 4 + (threadIdx.x >> 6), lane = threadIdx.x & 63, tok = gw >> 3, h = gw & 7, c = h * 64 + lane;
    const float y = ymix[(size_t)tok * DM + 512 + c];
    const float mean = wave_sum(y) * (1.f / 64.f); const float d = y - mean;
    const float var = wave_sum(d * d) * (1.f / 64.f);
    const float yn = d * rsqrtf(var + GN_EPS) * gn_g[c] + gn_b[c];
    const size_t o = (size_t)tok * 512 + c;
    const float bonus = wave_sum(bf2f(R[o]) * bf2f(Kk[o]) * r_k[c]) * bf2f(V[o]);
    const float gate = zmix(z, tok, 1536 + c, mu);
    ymix[(size_t)tok * DM + 512 + c] = (yn + bonus) * silu(gate);
}
__global__ void __launch_bounds__(256) k_attn(const float* q, const float* kv, float* o) {
    __shared__ float sq[256], sp[256], red[4];
    const int tok = blockIdx.x >> 2, h = blockIdx.x & 3, b = tok >> 11, j = threadIdx.x;
    sq[j] = q[(size_t)tok * DM + h * 256 + j];
    __syncthreads();
    const float* kr = kv + (size_t)(b * MEML + j) * 2048 + h * 256;
    float s = 0.f;
    for (int d = 0; d < 256; ++d) s += sq[d] * kr[d];
    s *= 0.0625f;
    float mx = wave_max(s);
    if ((j & 63) == 0) red[j >> 6] = mx;
    __syncthreads();
    mx = fmaxf(fmaxf(red[0], red[1]), fmaxf(red[2], red[3]));
    const float e = __expf(s - mx);
    float sm = wave_sum(e);
    __syncthreads();
    if ((j & 63) == 0) red[j >> 6] = sm;
    sp[j] = e;
    __syncthreads();
    sm = red[0] + red[1] + red[2] + red[3];
    float acc = 0.f;
    const float* vb = kv + (size_t)(b * MEML) * 2048 + 1024 + h * 256 + j;
    for (int kx = 0; kx < 256; ++kx) acc += sp[kx] * vb[(size_t)kx * 2048];
    o[(size_t)tok * DM + h * 256 + j] = acc / sm;
}
}

extern "C" void kernel_launch(void* const* d_in, const int* in_sizes, int n_in, void* d_out, int out_size, void* d_ws, size_t ws_size, hipStream_t stream) {
    if (ws_size < 256 * MiB) { fprintf(stderr, "ws too small: %zu\n", ws_size); return; }
    const float* x = (const float*)d_in[0]; const float* mem = (const float*)d_in[1]; const float* ln_mix_g = (const float*)d_in[2]; const float* w_in = (const float*)d_in[3];
    const float* sgu_ln_g = (const float*)d_in[4]; const float* sgu_ln_b = (const float*)d_in[5]; const float* sgu_ws = (const float*)d_in[6]; const float* sgu_bs = (const float*)d_in[7];
    const float* sgu_out_g = (const float*)d_in[8]; const float* rw_mu = (const float*)d_in[9]; const float* rw_w0 = (const float*)d_in[10]; const float* rw_w2 = (const float*)d_in[11];
    const float* rw_a0 = (const float*)d_in[12]; const float* rw_a2 = (const float*)d_in[13]; const float* rw_k_k = (const float*)d_in[14]; const float* rw_k_a = (const float*)d_in[15];
    const float* rw_r_k = (const float*)d_in[16]; const float* rw_gn_g = (const float*)d_in[17]; const float* rw_gn_b = (const float*)d_in[18]; const float* w_out = (const float*)d_in[19];
    const float* ln_x_g = (const float*)d_in[20]; const float* ln_mem_g = (const float*)d_in[21]; const float* w_q = (const float*)d_in[22]; const float* w_kv = (const float*)d_in[23];
    const float* w_o = (const float*)d_in[24]; const float* ln_f_g = (const float*)d_in[25];
    float* out = (float*)d_out; unsigned char* ws = (unsigned char*)d_ws;
    bf16* z = (bf16*)ws;
    float* bufA = (float*)(ws + 116 * MiB);
    unsigned char* bufB = ws + 180 * MiB;
    float* mn = (float*)(ws + 244 * MiB);
    float* xn = bufA; float* ymix = bufA; float* o = bufA;
    float* vln = (float*)bufB;
    bf16* R = (bf16*)bufB; bf16* Kk = (bf16*)(bufB + 16 * MiB); bf16* V = (bf16*)(bufB + 32 * MiB); bf16* KK = (bf16*)(bufB + 48 * MiB);
    float* W = out; float* ICL = out + (size_t)M * 512;
    float* hn = (float*)ws; float* kv = (float*)(ws + 64 * MiB); float* q = (float*)bufB;

    k_rmsnorm_rows<<<M / 4, 256, 0, stream>>>(x, ln_mix_g, xn, M);
    k_gemm<0><<<dim3(CIN / 64, M / 64), 256, 0, stream>>>(xn, w_in, M, CIN, DM, nullptr, z, nullptr);
    k_sgu_ln<<<M / 4, 256, 0, stream>>>(z, sgu_ln_g, sgu_ln_b, vln);
    k_sgu_mix<<<M, 512, 0, stream>>>(z, vln, sgu_ws, sgu_bs, sgu_out_g, ymix);
    k_rw_prep<<<M, 512, 0, stream>>>(z, rw_mu, rw_w0, rw_w2, rw_a0, rw_a2, rw_k_k, rw_k_a, R, Kk, V, KK, W, ICL);
    k_rw_scan<<<64, 64, 0, stream>>>(R, Kk, V, KK, W, ICL, ymix);
    k_rw_post<<<M * 8 / 4, 256, 0, stream>>>(z, rw_mu, R, Kk, V, rw_r_k, rw_gn_g, rw_gn_b, ymix);
    k_gemm<2><<<dim3(DM / 64, M / 64), 256, 0, stream>>>(ymix, w_out, M, DM, DM, out, nullptr, x);
    k_rmsnorm_rows<<<M / 4, 256, 0, stream>>>(out, ln_x_g, hn, M);
    k_rmsnorm_rows<<<MM / 4, 256, 0, stream>>>(mem, ln_mem_g, mn, MM);
    k_gemm<1><<<dim3(DM / 64, M / 64), 256, 0, stream>>>(hn, w_q, M, DM, DM, q, nullptr, nullptr);
    k_gemm<1><<<dim3(2048 / 64, MM / 64), 256, 0, stream>>>(mn, w_kv, MM, 2048, DM, kv, nullptr, nullptr);
    k_attn<<<M * 4, 256, 0, stream>>>(q, kv, o);
    k_gemm<2><<<dim3(DM / 64, M / 64), 256, 0, stream>>>(o, w_o, M, DM, DM, out, nullptr, out);
    k_rmsnorm_rows<<<M / 4, 256, 0, stream>>>(out, ln_f_g, out, M);
}
```

```cpp
#include <hip/hip_runtime.h>
#include <hip/hip_cooperative_groups.h>
#include <cstdio>
#include <cstdint>
namespace cg = cooperative_groups;
namespace pg8 {
#define PG8_LAS __attribute__((address_space(3)))
typedef unsigned short bf16_t;
typedef short bf16x8 __attribute__((ext_vector_type(8)));
typedef float f32x4 __attribute__((ext_vector_type(4)));
typedef unsigned u32x4 __attribute__((ext_vector_type(4)));
constexpr int BM = 256, BK = 64, HALF = 128, HTB = HALF * BK * 2  , STAGE_BYTES = 8 * HTB, NXCD = 8, WGM = 8;

__host__ __device__ __forceinline__ int lds_byte(int r, int c) { const int st = (r >> 4) * 2 + (c >> 5), rr = r & 15, cc = c & 31, ob = rr * 64 + cc * 2; return st * 1024 + (ob ^ (((ob >> 9) & 1) << 5)); }
__host__ __device__ __forceinline__ void stage_rc(int b, int& R, int& C) { const int st = b / 1024, sb = b % 1024, swz = sb ^ (((sb >> 9) & 1) << 5); R = (st >> 1) * 16 + swz / 64; C = (st & 1) * 32 + (swz % 64) / 2; }
__host__ __device__ __forceinline__ int perm32(int rho) { const int n = rho >> 4, i = rho & 15; return 8 * (i >> 2) + 4 * n + (i & 3); }

struct Unit { int pm, pn; };
struct Gemm { const bf16_t* A; const bf16_t* Bt; int M, N, K; };

struct StaticOrder {
    int nM, nN, nwg, G, c;
    __host__ __device__ void init(int M, int N, int G_, int c_) { nM = M / BM; nN = N / BM; nwg = nM * nN; G = G_; c = c_; }
    __host__ __device__ bool next(int i, Unit& u) const {
        const long L = (long)i * G + c; if (L >= nwg) return false;
        int wgid = (int)L; { const int q = nwg / NXCD, r = nwg % NXCD, xcd = wgid % NXCD, off = wgid / NXCD; wgid = (xcd < r ? xcd * (q + 1) : r * (q + 1) + (xcd - r) * q) + off; }
        const int nig = WGM * nN, gid = wgid / nig, fm = gid * WGM, gsz = (nM - fm) < WGM ? (nM - fm) : WGM;
        u.pm = fm + ((wgid % nig) % gsz); u.pn = (wgid % nig) / gsz; return true;
    }
    __device__ __forceinline__ void a_ready(const Unit&) const {}
    __device__ __forceinline__ void done(const Unit&) const {}
};

__device__ __forceinline__ unsigned cvt_pk_bf16(float lo, float hi) { unsigned r; asm volatile("v_cvt_pk_bf16_f32 %0, %1, %2" : "=v"(r) : "v"(lo), "v"(hi)); return r; }
typedef float f32x2 __attribute__((ext_vector_type(2)));
__device__ __forceinline__ f32x2 gelu_pk(f32x2 v) {
    const f32x2 av = __builtin_elementwise_abs(v), d = av * 0.2316418882f + 1.0f;
    f32x2 t; t.x = __builtin_amdgcn_rcpf(d.x); t.y = __builtin_amdgcn_rcpf(d.y);
    f32x2 q = t * 0.5307027145f + (-0.7265760135f); q = q * t + 0.7107068705f; q = q * t + (-0.142248368f); q = q * t + 0.127414796f; q = q * t;
    const f32x2 s = (v * v) * (-0.72134752044f);
    f32x2 e; e.x = __builtin_amdgcn_exp2f(s.x); e.y = __builtin_amdgcn_exp2f(s.y);
    const f32x2 m = v * (q * e), r = v - m;
    f32x2 o; o.x = v.x < 0.f ? m.x : r.x; o.y = v.y < 0.f ? m.y : r.y; return o;
}

template <int ACT  > struct EpiBf16 {
    static constexpr bool PERM = true, AFTER_DRAIN = false; static_assert(ACT == 0 || ACT == 1, "EpiBf16: ACT is 0 (none) or 1 (gelu_pk)");
    bf16_t* O; int ldc; const float* bias; int split_cols; size_t split_stride; float scale0;
    __device__ __forceinline__ void operator()(const f32x4 (&acc)[2][2][4][2], const Unit& u, int wr, int wc, int fr, int fq) const {
        const int row0 = u.pm * BM + wr * 64 + fr; int colt = u.pn * BM; bf16_t* base = O;
        float sc = 1.f; if (split_cols) { const int t = colt / split_cols; base += (size_t)t * split_stride; colt -= t * split_cols; if (t == 0) sc = scale0; }
        const int col0 = colt + wc * 32 + 8 * fq, bcol0 = u.pn * BM + wc * 32 + 8 * fq;
        f32x4 bv[2][2];
#pragma unroll
        for (int bj = 0; bj < 2; ++bj)
#pragma unroll
            for (int n = 0; n < 2; ++n) bv[bj][n] = bias ? *(const f32x4*)(bias + bcol0 + bj * HALF + 4 * n) : (f32x4){0.f, 0.f, 0.f, 0.f};
#pragma unroll
        for (int ai = 0; ai < 2; ++ai)
#pragma unroll
            for (int m = 0; m < 4; ++m) { bf16_t* rowp = base + (size_t)(row0 + ai * HALF + m * 16) * ldc + col0;
#pragma unroll
                for (int bj = 0; bj < 2; ++bj) { f32x4 v0 = acc[ai][bj][m][0] + bv[bj][0], v1 = acc[ai][bj][m][1] + bv[bj][1];
                    if (ACT == 1) { f32x2 a = gelu_pk((f32x2){v0[0], v0[1]}), b = gelu_pk((f32x2){v0[2], v0[3]}), c = gelu_pk((f32x2){v1[0], v1[1]}), d = gelu_pk((f32x2){v1[2], v1[3]});
                        v0 = (f32x4){a.x, a.y, b.x, b.y}; v1 = (f32x4){c.x, c.y, d.x, d.y}; }
                    v0 = v0 * sc; v1 = v1 * sc; u32x4 w; w.x = cvt_pk_bf16(v0[0], v0[1]); w.y = cvt_pk_bf16(v0[2], v0[3]); w.z = cvt_pk_bf16(v1[0], v1[1]); w.w = cvt_pk_bf16(v1[2], v1[3]);
                    *(u32x4*)(rowp + bj * HALF) = w; } }
    }
};
template <class Epi, class Sched, bool ALIGN_EPI = false, bool SP2 = false>
__device__ __forceinline__ void gemm_phase(PG8_LAS unsigned char* lds, const Gemm g, const Sched& S, const Epi& E) {
    const int tid = threadIdx.x, wid = __builtin_amdgcn_readfirstlane(tid >> 6), lane = tid & 63, wr = wid >> 2, wc = wid & 3, fr = lane & 15, fq = lane >> 4;
    const int K = g.K, nt = K / BK;
    unsigned voffA[2], voffB[2];
#pragma unroll
    for (int i = 0; i < 2; ++i) { int R, C; stage_rc(tid * 16 + i * 8192, R, C); const int Rb = Epi::PERM ? ((R & ~31) + perm32(R & 31)) : R;
        voffA[i] = (unsigned)(R * K + C) * 2u; voffB[i] = (unsigned)(Rb * K + C) * 2u; }
    const size_t kstep = (size_t)(BK * 2);
    const size_t hstep = (size_t)HALF * K * 2;
    const size_t tstep = 2 * hstep;
    const unsigned ldsw = (unsigned)wid * 1024u;
    const int aoff = lds_byte(wr * 64 + fr, fq * 8), boff = lds_byte(wc * 32 + fr, fq * 8);
#define PG8_SA(b, h) (((b) * 2 + (h)) * HTB)
#define PG8_SB(b, h) ((4 + (b) * 2 + (h)) * HTB)
#define PG8_STAGE(bufoff, gbase, voff) do { _Pragma("unroll") for (int _i = 0; _i < 2; ++_i) \
        __builtin_amdgcn_global_load_lds((const unsigned*)((const char*)(gbase) + (voff)[_i]), (PG8_LAS unsigned*)(lds + (bufoff) + ldsw + _i * 8192), 16, 0, 0); } while (0)
#define PG8_LDA(dst, b, h) do { _Pragma("unroll") for (int m = 0; m < 4; ++m) _Pragma("unroll") for (int k = 0; k < 2; ++k) dst[m][k] = *(const PG8_LAS bf16x8*)(lds + PG8_SA(b, h) + aoff + m * 2048 + k * 1024); } while (0)
#define PG8_LDB(dst, b, h) do { _Pragma("unroll") for (int n = 0; n < 2; ++n) _Pragma("unroll") for (int k = 0; k < 2; ++k) dst[n][k] = *(const PG8_LAS bf16x8*)(lds + PG8_SB(b, h) + boff + n * 2048 + k * 1024); } while (0)
#define PG8_MMA(ai, bj, At, Bt) do { __builtin_amdgcn_s_setprio(1); _Pragma("unroll") for (int m = 0; m < 4; ++m) _Pragma("unroll") for (int n = 0; n < 2; ++n) _Pragma("unroll") for (int k = 0; k < 2; ++k) \
        acc[ai][bj][m][n] = __builtin_amdgcn_mfma_f32_16x16x32_bf16(Bt[n][k], At[m][k], acc[ai][bj][m][n], 0, 0, 0); __builtin_amdgcn_s_setprio(0); } while (0)
#define PG8_WAIT_V(n) asm volatile("s_waitcnt vmcnt(" #n ")" ::: "memory")
#define PG8_WAIT_L(n) asm volatile("s_waitcnt lgkmcnt(" #n ")" ::: "memory")
#define PG8_BAR __builtin_amdgcn_s_barrier()
#define PG8_SCHED __builtin_amdgcn_sched_barrier(0)
    Unit cur, nxt; int ui = 0;
    if (!S.next(0, cur)) return;
    f32x4 acc[2][2][4][2];
#pragma unroll
    for (int a = 0; a < 2; ++a)
#pragma unroll
        for (int b = 0; b < 2; ++b)
#pragma unroll
            for (int m = 0; m < 4; ++m)
#pragma unroll
                for (int n = 0; n < 2; ++n) acc[a][b][m][n] = (f32x4){0.f, 0.f, 0.f, 0.f};
    bf16x8 At[4][2], B0[2][2], B1[2][2];
    const char* cA = (const char*)g.A + (size_t)cur.pm * tstep; const char* cB = (const char*)g.Bt + (size_t)cur.pn * tstep;
    S.a_ready(cur);
    if constexpr (SP2) {
        PG8_STAGE(PG8_SB(0, 0), cB, voffB); PG8_STAGE(PG8_SB(0, 1), cB + hstep, voffB); PG8_STAGE(PG8_SA(0, 0), cA, voffA); PG8_STAGE(PG8_SA(0, 1), cA + hstep, voffA);
        if (wr == 1) PG8_BAR;
        PG8_WAIT_V(2); PG8_BAR;
        PG8_STAGE(PG8_SB(1, 0), cB + kstep, voffB); PG8_STAGE(PG8_SA(1, 0), cA + kstep, voffA); PG8_STAGE(PG8_SB(1, 1), cB + hstep + kstep, voffB);
        PG8_WAIT_V(6); PG8_BAR;
    } else {
        PG8_STAGE(PG8_SB(0, 0), cB, voffB); PG8_STAGE(PG8_SA(0, 0), cA, voffA); PG8_STAGE(PG8_SB(0, 1), cB + hstep, voffB); PG8_STAGE(PG8_SA(0, 1), cA + hstep, voffA);
        if (wr == 1) PG8_BAR;
        PG8_WAIT_V(4); PG8_BAR;
        PG8_STAGE(PG8_SB(1, 0), cB + kstep, voffB); PG8_STAGE(PG8_SA(1, 0), cA + kstep, voffA); PG8_STAGE(PG8_SB(1, 1), cB + hstep + kstep, voffB);
        PG8_WAIT_V(6); PG8_BAR;
    }
    for (;;) {
        const bool has_next = S.next(ui + 1, nxt);
        const char* nA = has_next ? (const char*)g.A + (size_t)nxt.pm * tstep : cA; const char* nB = has_next ? (const char*)g.Bt + (size_t)nxt.pn * tstep : cB;
        for (int t = 0; t < nt; t += 2) {
            const bool last = (t == nt - 2);
            const char* a1 = cA + (size_t)(t + 1) * kstep;
            const char* a2 = last ? nA : cA + (size_t)(t + 2) * kstep; const char* b2 = last ? nB : cB + (size_t)(t + 2) * kstep;
            const char* a3 = a2 + kstep; const char* b3 = b2 + kstep;
            if (last && has_next) S.a_ready(nxt);
            if constexpr (SP2) {
            PG8_LDB(B0, 0, 0); PG8_LDB(B1, 0, 1); PG8_SCHED; PG8_LDA(At, 0, 0); PG8_STAGE(PG8_SA(1, 1), a1 + hstep, voffA);
            PG8_WAIT_V(8); PG8_WAIT_L(0); PG8_BAR; PG8_MMA(0, 0, At, B0); PG8_MMA(0, 1, At, B1); PG8_BAR; PG8_SCHED;
            PG8_LDA(At, 0, 1); PG8_STAGE(PG8_SB(0, 0), b2, voffB); PG8_STAGE(PG8_SB(0, 1), b2 + hstep, voffB); PG8_STAGE(PG8_SA(0, 0), a2, voffA);
            PG8_WAIT_V(8); PG8_WAIT_L(0); PG8_BAR; PG8_MMA(1, 0, At, B0); PG8_MMA(1, 1, At, B1); PG8_BAR; PG8_SCHED;
            PG8_LDB(B0, 1, 0); PG8_LDB(B1, 1, 1); PG8_SCHED; PG8_LDA(At, 1, 0); PG8_STAGE(PG8_SA(0, 1), a2 + hstep, voffA);
            PG8_WAIT_V(8); PG8_WAIT_L(0); PG8_BAR; PG8_MMA(0, 0, At, B0); PG8_MMA(0, 1, At, B1); PG8_BAR; PG8_SCHED;
            PG8_LDA(At, 1, 1); PG8_STAGE(PG8_SB(1, 0), b3, voffB); PG8_STAGE(PG8_SB(1, 1), b3 + hstep, voffB); PG8_STAGE(PG8_SA(1, 0), a3, voffA);
            PG8_WAIT_V(8); PG8_WAIT_L(0); PG8_BAR; PG8_MMA(1, 0, At, B0); PG8_MMA(1, 1, At, B1); PG8_BAR; PG8_SCHED;
            } else {
            PG8_LDB(B0, 0, 0); PG8_SCHED; PG8_LDA(At, 0, 0); PG8_STAGE(PG8_SA(1, 1), a1 + hstep, voffA);
            PG8_WAIT_L(8); PG8_BAR; PG8_WAIT_L(0); PG8_MMA(0, 0, At, B0); PG8_BAR; PG8_SCHED;
            PG8_LDB(B1, 0, 1); PG8_STAGE(PG8_SB(0, 0), b2, voffB);
            PG8_BAR; PG8_WAIT_L(0); PG8_MMA(0, 1, At, B1); PG8_BAR;
            PG8_LDA(At, 0, 1); PG8_STAGE(PG8_SA(0, 0), a2, voffA);
            PG8_BAR; PG8_WAIT_L(0); PG8_MMA(1, 0, At, B0); PG8_BAR; PG8_SCHED;
            PG8_STAGE(PG8_SB(0, 1), b2 + hstep, voffB);
            PG8_WAIT_V(6); PG8_BAR; PG8_MMA(1, 1, At, B1); PG8_BAR;
            PG8_LDB(B0, 1, 0); PG8_SCHED; PG8_LDA(At, 1, 0); PG8_STAGE(PG8_SA(0, 1), a2 + hstep, voffA);
            PG8_WAIT_L(8); PG8_BAR; PG8_WAIT_L(0); PG8_MMA(0, 0, At, B0); PG8_BAR; PG8_SCHED;
            PG8_LDB(B1, 1, 1); PG8_STAGE(PG8_SB(1, 0), b3, voffB);
            PG8_BAR; PG8_WAIT_L(0); PG8_MMA(0, 1, At, B1); PG8_BAR;
            PG8_LDA(At, 1, 1); PG8_STAGE(PG8_SA(1, 0), a3, voffA);
            PG8_BAR; PG8_WAIT_L(0); PG8_MMA(1, 0, At, B0); PG8_BAR; PG8_SCHED;
            PG8_STAGE(PG8_SB(1, 1), b3 + hstep, voffB);
            PG8_WAIT_V(6); PG8_BAR; PG8_MMA(1, 1, At, B1); PG8_BAR;
            }
        }
        if constexpr (ALIGN_EPI) { if (wr == 0) PG8_BAR; }
        if constexpr (!Epi::AFTER_DRAIN) { E(acc, cur, wr, wc, fr, fq); S.done(cur); }
        if (!has_next) break;
#pragma unroll
        for (int a = 0; a < 2; ++a)
#pragma unroll
            for (int b = 0; b < 2; ++b)
#pragma unroll
                for (int m = 0; m < 4; ++m)
#pragma unroll
                    for (int n = 0; n < 2; ++n) acc[a][b][m][n] = (f32x4){0.f, 0.f, 0.f, 0.f};
        cur = nxt; cA = nA; cB = nB; ++ui;
        if constexpr (ALIGN_EPI) { if (wr == 1) PG8_BAR; }
    }
    PG8_WAIT_V(0);
    if constexpr (!ALIGN_EPI) { if (wr == 0) PG8_BAR; }
    PG8_BAR;
    if constexpr (Epi::AFTER_DRAIN) { E.fused(acc, cur, wr, wc, fr, fq, lds, wid, lane); S.done(cur); }
#undef PG8_SA
#undef PG8_SB
#undef PG8_STAGE
#undef PG8_LDA
#undef PG8_LDB
#undef PG8_MMA
#undef PG8_WAIT_V
#undef PG8_WAIT_L
#undef PG8_BAR
#undef PG8_SCHED
}
}
namespace pg8 {
struct EpiResid {
    static constexpr bool PERM = false, AFTER_DRAIN = false;
    const float* base; float* out; bf16_t* hg; const float* g; float* rowss;
    __device__ __forceinline__ void operator()(const f32x4 (&acc)[2][2][4][2], const Unit& u, int wr, int wc, int fr, int fq) const {
        typedef unsigned u32x2v __attribute__((ext_vector_type(2)));
        const int col0 = u.pn * BM + wc * 32 + 4 * fq;
#pragma unroll
        for (int ai = 0; ai < 2; ++ai)
#pragma unroll
            for (int m = 0; m < 4; ++m) {
                const int row = u.pm * BM + ai * HALF + wr * 64 + m * 16 + fr; const size_t off = (size_t)row * 1024 + col0; float ss = 0.f;
#pragma unroll
                for (int bj = 0; bj < 2; ++bj)
#pragma unroll
                    for (int n = 0; n < 2; ++n) { const int c = bj * HALF + n * 16;
                        const f32x4 v = *(const f32x4*)(base + off + c) + acc[ai][bj][m][n];
                        *(f32x4*)(out + off + c) = v; ss += (v[0] * v[0] + v[1] * v[1]) + (v[2] * v[2] + v[3] * v[3]);
                        if (hg) { const f32x4 w = v * *(const f32x4*)(g + col0 + c); u32x2v p; p.x = cvt_pk_bf16(w[0], w[1]); p.y = cvt_pk_bf16(w[2], w[3]); *(u32x2v*)(hg + off + c) = p; } }
                ss += __shfl_xor(ss, 16); ss += __shfl_xor(ss, 32);
                if (fq == 0) atomicAdd(rowss + row, ss);
                asm volatile("" ::: "memory");
            }
    }
};
struct EpiScaleBf16 {
    static constexpr bool PERM = true, AFTER_DRAIN = false;
    bf16_t* O; const float* rowss; float mul, eps;
    __device__ __forceinline__ void operator()(const f32x4 (&acc)[2][2][4][2], const Unit& u, int wr, int wc, int fr, int fq) const {
        const int col0 = u.pn * BM + wc * 32 + 8 * fq;
#pragma unroll
        for (int ai = 0; ai < 2; ++ai)
#pragma unroll
            for (int m = 0; m < 4; ++m) {
                const int row = u.pm * BM + ai * HALF + wr * 64 + m * 16 + fr; const float rs = rsqrtf(rowss[row] * (1.f / 1024.f) + eps) * mul;
                bf16_t* rowp = O + (size_t)row * 1024 + col0;
#pragma unroll
                for (int bj = 0; bj < 2; ++bj) { const f32x4 v0 = acc[ai][bj][m][0] * rs, v1 = acc[ai][bj][m][1] * rs;
                    u32x4 w; w.x = cvt_pk_bf16(v0[0], v0[1]); w.y = cvt_pk_bf16(v0[2], v0[3]); w.z = cvt_pk_bf16(v1[0], v1[1]); w.w = cvt_pk_bf16(v1[2], v1[3]);
                    *(u32x4*)(rowp + bj * HALF) = w; }
            }
    }
};
}
namespace mk {
#define LAS __attribute__((address_space(3)))
typedef unsigned short bf16;
typedef float f32x4 __attribute__((ext_vector_type(4)));
typedef unsigned v4u __attribute__((ext_vector_type(4)));
constexpr int NB = 8, SEQ = 2048, DM = 1024, M = NB * SEQ, MEML = 256, MM = NB * MEML;
constexpr int CSGU = 1536, CIN = 3712, ZP = 3840, CH = 128;
constexpr float RMS_EPS = 1e-6f, LN_EPS = 1e-5f, GN_EPS = 64e-5f;
constexpr float QSCALE = 0.0625f * 1.4426950408889634f;
constexpr size_t MiB = 1u << 20;
constexpr int NWAVES = 8, NT = 512, LDS_BYTES = 147456;
constexpr size_t WS_ROWSS1 = 0, WS_ROWSS2 = 65536;
constexpr size_t WS_WIN = 1 * MiB, WS_WKV = WS_WIN + (size_t)ZP * DM * 2, WS_WOUT = WS_WKV + 4 * MiB, WS_WQ = WS_WOUT + 2 * MiB, WS_WO = WS_WQ + 2 * MiB;
static_assert(WS_WO + 2 * MiB <= 20 * MiB, "weights");
constexpr size_t WS_XN = 20 * MiB, WS_YMIX = 20 * MiB, WS_MN = 52 * MiB, WS_KV = 56 * MiB, WS_Z = 64 * MiB;
constexpr size_t WS_YSCAN = 64 * MiB, WS_HG = 96 * MiB, WS_Q = 128 * MiB, WS_O = 160 * MiB;
constexpr size_t WS_R = 184 * MiB, WS_K = 200 * MiB, WS_V = 216 * MiB, WS_KK = 232 * MiB, WS_END = 256 * MiB;

struct Args { const float* in[26]; float* out; unsigned char* ws; };

#define LDS_WAIT() asm volatile("s_waitcnt lgkmcnt(0)" ::: "memory")
__device__ __forceinline__ unsigned f2bf(float f) { unsigned u = __builtin_bit_cast(unsigned, f); return (u + 0x7fffu + ((u >> 16) & 1u)) >> 16; }
__device__ __forceinline__ unsigned pk2(float lo, float hi) { return f2bf(lo) | (f2bf(hi) << 16); }
__device__ __forceinline__ float bf2f(bf16 h) { return __uint_as_float(((unsigned)h) << 16); }
__device__ __forceinline__ float wave_sum(float v) {
#pragma unroll
    for (int o = 1; o < 64; o <<= 1) v += __shfl_xor(v, o);
    return v;
}
__device__ __forceinline__ float wave_max(float v) {
#pragma unroll
    for (int o = 1; o < 64; o <<= 1) v = fmaxf(v, __shfl_xor(v, o));
    return v;
}
__device__ __forceinline__ float gelu_exact(float x) { return 0.5f * x * (1.f + erff(x * 0.70710678118654752f)); }
__device__ __forceinline__ float silu(float x) { return x / (1.f + __expf(-x)); }
__device__ __forceinline__ float sigmoidf(float x) { return 1.f / (1.f + __expf(-x)); }

__device__ __forceinline__ void p0_transpose_item(const float* W, int K, int N, bf16* WT, LAS float* scr, int item, int lane) {
    const int nblk = N / 32, kb = item / nblk, nb = item % nblk, k0 = 64 * kb, n0 = 32 * nb;
#pragma unroll 8
    for (int i = 0; i < 32; ++i) { const int kk = 2 * i + (lane >> 5); scr[kk * 33 + (lane & 31)] = W[(size_t)(k0 + kk) * N + n0 + (lane & 31)]; }
    LDS_WAIT();
    const int c = lane & 7;
#pragma unroll
    for (int j = 0; j < 4; ++j) { const int n = (lane >> 3) + 8 * j; const LAS float* s = scr + (8 * c) * 33 + n;
        v4u o; o.x = pk2(s[0 * 33], s[1 * 33]); o.y = pk2(s[2 * 33], s[3 * 33]); o.z = pk2(s[4 * 33], s[5 * 33]); o.w = pk2(s[6 * 33], s[7 * 33]);
        *(v4u*)(WT + (size_t)(n0 + n) * K + k0 + 8 * c) = o; }
    LDS_WAIT();
}
__device__ __forceinline__ void rms_row_to_bf16(const float* xrow, const float* g, bf16* orow, int lane) {
    const f32x4* xr = (const f32x4*)xrow + lane; const f32x4* gr = (const f32x4*)g + lane;
    f32x4 v[4]; float s = 0.f;
#pragma unroll
    for (int j = 0; j < 4; ++j) { v[j] = xr[64 * j]; s += (v[j].x * v[j].x + v[j].y * v[j].y) + (v[j].z * v[j].z + v[j].w * v[j].w); }
    const float rs = rsqrtf(wave_sum(s) * (1.f / DM) + RMS_EPS);
    unsigned long long* o8 = (unsigned long long*)orow + lane;
#pragma unroll
    for (int j = 0; j < 4; ++j) { const f32x4 w = v[j] * rs * gr[64 * j]; o8[64 * j] = (unsigned long long)pk2(w.x, w.y) | ((unsigned long long)pk2(w.z, w.w) << 32); }
}
__device__ __forceinline__ float zmix(const bf16* z, int tok, int j, const float* mu) {
    const float zt = bf2f(z[(size_t)tok * ZP + CSGU + j]);
    const float zp = (tok & (SEQ - 1)) ? bf2f(z[(size_t)(tok - 1) * ZP + CSGU + j]) : 0.f;
    return zt + (zp - zt) * mu[j];
}

__global__ void __launch_bounds__(NT, 2) fwd(Args args) {
    extern __shared__ __attribute__((aligned(16))) unsigned char lds_raw[];
    LAS unsigned char* lds = (LAS unsigned char*)lds_raw;
    cg::grid_group grid = cg::this_grid();
    const int tid = threadIdx.x, lane = tid & 63, wave = __builtin_amdgcn_readfirstlane(tid >> 6);
    const int G = gridDim.x, bid = blockIdx.x, gw = bid * NWAVES + wave, NGW = G * NWAVES;
    unsigned char* ws = args.ws; float* out = args.out;
    const float* x = args.in[0]; const float* mem = args.in[1]; const float* ln_mix_g = args.in[2]; const float* w_in = args.in[3];
    const float* sgu_ln_g = args.in[4]; const float* sgu_ln_b = args.in[5]; const float* sgu_ws = args.in[6]; const float* sgu_bs = args.in[7];
    const float* sgu_out_g = args.in[8]; const float* rw_mu = args.in[9]; const float* rw_w0 = args.in[10]; const float* rw_w2 = args.in[11];
    const float* rw_a0 = args.in[12]; const float* rw_a2 = args.in[13]; const float* rw_k_k = args.in[14]; const float* rw_k_a = args.in[15];
    const float* rw_r_k = args.in[16]; const float* rw_gn_g = args.in[17]; const float* rw_gn_b = args.in[18]; const float* w_out = args.in[19];
    const float* ln_x_g = args.in[20]; const float* ln_mem_g = args.in[21]; const float* w_q = args.in[22]; const float* w_kv = args.in[23];
    const float* w_o = args.in[24]; const float* ln_f_g = args.in[25];
    float* rowss1 = (float*)(ws + WS_ROWSS1); float* rowss2 = (float*)(ws + WS_ROWSS2);
    bf16* WinT = (bf16*)(ws + WS_WIN); bf16* WkvT = (bf16*)(ws + WS_WKV); bf16* WoutT = (bf16*)(ws + WS_WOUT); bf16* WqT = (bf16*)(ws + WS_WQ); bf16* WoT = (bf16*)(ws + WS_WO);
    bf16* xn = (bf16*)(ws + WS_XN); bf16* ymix = (bf16*)(ws + WS_YMIX); bf16* mn = (bf16*)(ws + WS_MN); bf16* kv = (bf16*)(ws + WS_KV); bf16* z = (bf16*)(ws + WS_Z);
    float* yscan = (float*)(ws + WS_YSCAN); bf16* hg = (bf16*)(ws + WS_HG); bf16* q = (bf16*)(ws + WS_Q); bf16* o = (bf16*)(ws + WS_O);
    bf16* R = (bf16*)(ws + WS_R); bf16* Kk = (bf16*)(ws + WS_K); bf16* V = (bf16*)(ws + WS_V); bf16* KK = (bf16*)(ws + WS_KK);
    float* Wd = out; bf16* ICL = (bf16*)(out + (size_t)M * 512); bf16* Gt = ICL + (size_t)M * 512; float* vln = out;

#ifndef NO_P0
    {
        LAS float* scr = (LAS float*)(lds + wave * 16384);
        constexpr int I_IN = 16 * (CIN / 32), I_KV = 16 * 64, I_SQ = 16 * 32, NITEMS = I_IN + I_KV + 3 * I_SQ;
        for (int it = gw; it < NITEMS; it += NGW) {
            int r = it;
            if (r < I_IN) { p0_transpose_item(w_in, DM, CIN, WinT, scr, r, lane); continue; } r -= I_IN;
            if (r < I_KV) { p0_transpose_item(w_kv, DM, 2048, WkvT, scr, r, lane); continue; } r -= I_KV;
            if (r < I_SQ) { p0_transpose_item(w_out, DM, DM, WoutT, scr, r, lane); continue; } r -= I_SQ;
            if (r < I_SQ) { p0_transpose_item(w_q, DM, DM, WqT, scr, r, lane); continue; } r -= I_SQ;
            p0_transpose_item(w_o, DM, DM, WoT, scr, r, lane);
        }
        for (int i = bid * NT + tid; i < (ZP - CIN) * DM / 8; i += G * NT) ((v4u*)(WinT + (size_t)CIN * DM))[i] = (v4u){0u, 0u, 0u, 0u};
        for (int i = bid * NT + tid; i < M; i += G * NT) { rowss1[i] = 0.f; rowss2[i] = 0.f; }
        for (int m = gw; m < M; m += NGW) rms_row_to_bf16(x + (size_t)m * DM, ln_mix_g, xn + (size_t)m * DM, lane);
        for (int m = gw; m < MM; m += NGW) rms_row_to_bf16(mem + (size_t)m * DM, ln_mem_g, mn + (size_t)m * DM, lane);
    }
#endif
    grid.sync();
#ifndef NO_P1
    {
        pg8::Gemm g{xn, WinT, M, ZP, DM}; pg8::StaticOrder S; S.init(M, ZP, G, bid);
        pg8::EpiBf16<0> E{z, ZP, nullptr, 0, 0, 1.f};
        pg8::gemm_phase<pg8::EpiBf16<0>, pg8::StaticOrder, true, true>(lds, g, S, E);
    }
    {
        pg8::Gemm g{mn, WkvT, MM, 2048, DM}; pg8::StaticOrder S; S.init(MM, 2048, G, bid);
        pg8::EpiBf16<0> E{kv, 2048, nullptr, 0, 0, 1.f};
        pg8::gemm_phase<pg8::EpiBf16<0>, pg8::StaticOrder, true, true>(lds, g, S, E);
    }
#endif
    grid.sync();
#ifndef NO_P2a
    for (int tok = gw; tok < M; tok += NGW) {
        const bf16* zr = z + (size_t)tok * ZP + 512; float v[8]; float s = 0.f;
#pragma unroll
        for (int j = 0; j < 8; ++j) { v[j] = gelu_exact(bf2f(zr[lane + 64 * j])); s += v[j]; }
        const float mu = wave_sum(s) * (1.f / 512.f); float qq = 0.f;
#pragma unroll
        for (int j = 0; j < 8; ++j) { v[j] -= mu; qq += v[j] * v[j]; }
        const float rs = rsqrtf(wave_sum(qq) * (1.f / 512.f) + LN_EPS);
#pragma unroll
        for (int j = 0; j < 8; ++j) vln[(size_t)tok * 512 + lane + 64 * j] = v[j] * rs * sgu_ln_g[lane + 64 * j] + sgu_ln_b[lane + 64 * j];
    }
#endif
    grid.sync();
#ifndef NO_P2b
    {
        LAS float* red = (LAS float*)lds;
        for (int tok = bid; tok < M; tok += G) {
            const int f = tid, h = f >> 7, t = tok & 127, c0 = tok - t;
            const float* wr = sgu_ws + ((size_t)h * CH + t) * CH;
            float sv = sgu_bs[h * CH + t];
            for (int s = 0; s <= t; ++s) sv += wr[s] * vln[(size_t)(c0 + s) * 512 + f];
            const float u = gelu_exact(bf2f(z[(size_t)tok * ZP + f]));
            const float p = u * sv;
            const float ss = wave_sum(p * p);
            __syncthreads();
            if (lane == 0) red[wave] = ss;
            __syncthreads();
            float tot = 0.f;
#pragma unroll
            for (int i = 0; i < 8; ++i) tot += red[i];
            const float rs = rsqrtf(tot * (1.f / 512.f) + RMS_EPS);
            const float gate = bf2f(z[(size_t)tok * ZP + 1024 + f]);
            ymix[(size_t)tok * DM + f] = (bf16)f2bf(p * rs * sgu_out_g[f] * silu(gate));
        }
    }
#endif
    grid.sync();
#ifndef NO_P2c
    {
        LAS float* swd = (LAS float*)lds; LAS float* sad = swd + 64;
        for (int tok = bid; tok < M; tok += G) {
            const int c = tid;
            const float r = zmix(z, tok, c, rw_mu), k = zmix(z, tok, 512 + c, rw_mu), v = zmix(z, tok, 1024 + c, rw_mu), gt = zmix(z, tok, 1536 + c, rw_mu);
            __syncthreads();
            if (c < 64) swd[c] = tanhf(zmix(z, tok, 2048 + c, rw_mu));
            else if (c < 128) sad[c - 64] = zmix(z, tok, 2112 + (c - 64), rw_mu);
            __syncthreads();
            float lw = rw_w0[c], la = rw_a0[c];
#pragma unroll 4
            for (int j = 0; j < 64; ++j) { lw += swd[j] * rw_w2[j * 512 + c]; la += sad[j] * rw_a2[j * 512 + c]; }
            const float xx = -lw;
            const float sp = fmaxf(xx, 0.f) + log1pf(expf(-fabsf(xx)));
            const float decay = expf(-expf(-sp - 0.5f));
            const float ic = sigmoidf(la);
            float kk = k * rw_k_k[c];
            const float ss = wave_sum(kk * kk);
            kk *= rsqrtf(fmaxf(ss, 1e-24f));
            const float k2 = k * (1.f + (ic - 1.f) * rw_k_a[c]);
            const size_t oo = (size_t)tok * 512 + c;
            R[oo] = (bf16)f2bf(r); Kk[oo] = (bf16)f2bf(k2); V[oo] = (bf16)f2bf(v); KK[oo] = (bf16)f2bf(kk); Wd[oo] = decay; ICL[oo] = (bf16)f2bf(ic); Gt[oo] = (bf16)f2bf(silu(gt));
        }
    }
#endif
    grid.sync();
#ifndef NO_P3
    if (bid < 64 && wave == 0) {
        LAS float* sr = (LAS float*)lds; LAS float* sw = sr + 512; LAS float* sk = sw + 512; LAS float* sa = sk + 512; LAS float* sb = sa + 512; LAS float* svv = sb + 512;
        const int b = bid >> 3, h = bid & 7;
        float S[64];
#pragma unroll
        for (int j = 0; j < 64; ++j) S[j] = 0.f;
        for (int t0 = 0; t0 < SEQ; t0 += 8) {
            LDS_WAIT();
#pragma unroll
            for (int i = 0; i < 8; ++i) {
                const size_t oo = (size_t)(b * SEQ + t0 + i) * 512 + h * 64 + lane;
                const float kk = bf2f(KK[oo]);
                sr[i * 64 + lane] = bf2f(R[oo]); sw[i * 64 + lane] = Wd[oo]; sk[i * 64 + lane] = bf2f(Kk[oo]); sa[i * 64 + lane] = -kk; sb[i * 64 + lane] = kk * bf2f(ICL[oo]); svv[i * 64 + lane] = bf2f(V[oo]);
            }
            LDS_WAIT();
            for (int i = 0; i < 8; ++i) {
                float dot = 0.f;
#pragma unroll
                for (int j = 0; j < 64; ++j) dot += S[j] * sa[i * 64 + j];
                const float vv = svv[i * 64 + lane];
                float y = 0.f;
#pragma unroll
                for (int j = 0; j < 64; ++j) { S[j] = S[j] * sw[i * 64 + j] + dot * sb[i * 64 + j] + vv * sk[i * 64 + j]; y += S[j] * sr[i * 64 + j]; }
                yscan[(size_t)(b * SEQ + t0 + i) * 512 + h * 64 + lane] = y;
            }
        }
    }
#endif
    grid.sync();
#ifndef NO_P4
    for (int it = gw; it < M * 8; it += NGW) {
        const int tok = it >> 3, h = it & 7, c = h * 64 + lane; const size_t oo = (size_t)tok * 512 + c;
        const float y = yscan[oo];
        const float mean = wave_sum(y) * (1.f / 64.f); const float d = y - mean;
        const float var = wave_sum(d * d) * (1.f / 64.f);
        const float yn = d * rsqrtf(var + GN_EPS) * rw_gn_g[c] + rw_gn_b[c];
        const float bonus = wave_sum(bf2f(R[oo]) * bf2f(Kk[oo]) * rw_r_k[c]) * bf2f(V[oo]);
        ymix[(size_t)tok * DM + 512 + c] = (bf16)f2bf((yn + bonus) * bf2f(Gt[oo]));
    }
#endif
    grid.sync();
#ifndef NO_P5
    {
        pg8::Gemm g{ymix, WoutT, M, DM, DM}; pg8::StaticOrder S; S.init(M, DM, G, bid);
        pg8::EpiResid E{x, out, hg, ln_x_g, rowss1};
        pg8::gemm_phase<pg8::EpiResid, pg8::StaticOrder, false, true>(lds, g, S, E);
    }
#endif
    grid.sync();
#ifndef NO_P6
    {
        pg8::Gemm g{hg, WqT, M, DM, DM}; pg8::StaticOrder S; S.init(M, DM, G, bid);
        pg8::EpiScaleBf16 E{q, rowss1, QSCALE, RMS_EPS};
        pg8::gemm_phase<pg8::EpiScaleBf16, pg8::StaticOrder, false, true>(lds, g, S, E);
    }
#endif
    grid.sync();
#ifndef NO_P7
    {
        const int half = tid >> 8, j = tid & 255;
        LAS float* sq = (LAS float*)lds + half * 768; LAS float* sp = sq + 256; LAS float* red = sp + 256;
        for (int it = bid; it < M * 2; it += G) {
            const int tok = it >> 1, h = (it & 1) * 2 + half, b = tok >> 11;
            __syncthreads();
            sq[j] = bf2f(q[(size_t)tok * DM + h * 256 + j]);
            __syncthreads();
            const bf16* kr = kv + (size_t)(b * MEML + j) * 2048 + h * 256;
            float s = 0.f;
            for (int d = 0; d < 256; ++d) s += sq[d] * bf2f(kr[d]);
            float mx = wave_max(s);
            if (lane == 0) red[j >> 6] = mx;
            __syncthreads();
            mx = fmaxf(fmaxf(red[0], red[1]), fmaxf(red[2], red[3]));
            const float e = exp2f(s - mx);
            float sm = wave_sum(e);
            __syncthreads();
            if (lane == 0) red[j >> 6] = sm;
            sp[j] = e;
            __syncthreads();
            sm = red[0] + red[1] + red[2] + red[3];
            float acc = 0.f;
            const bf16* vb = kv + (size_t)(b * MEML) * 2048 + 1024 + h * 256 + j;
            for (int kx = 0; kx < 256; ++kx) acc += sp[kx] * bf2f(vb[(size_t)kx * 2048]);
            o[(size_t)tok * DM + h * 256 + j] = (bf16)f2bf(acc / sm);
        }
    }
#endif
    grid.sync();
#ifndef NO_P8
    {
        pg8::Gemm g{o, WoT, M, DM, DM}; pg8::StaticOrder S; S.init(M, DM, G, bid);
        pg8::EpiResid E{out, out, nullptr, nullptr, rowss2};
        pg8::gemm_phase<pg8::EpiResid, pg8::StaticOrder, false, true>(lds, g, S, E);
    }
#endif
    grid.sync();
#ifndef NO_P9
    for (int m = gw; m < M; m += NGW) {
        const float rs = rsqrtf(rowss2[m] * (1.f / DM) + RMS_EPS);
        f32x4* xr = (f32x4*)(out + (size_t)m * DM) + lane; const f32x4* gr = (const f32x4*)ln_f_g + lane;
#pragma unroll
        for (int j = 0; j < 4; ++j) xr[64 * j] = xr[64 * j] * rs * gr[64 * j];
    }
#endif
}
}

extern "C" void kernel_launch(void* const* d_in, const int* in_sizes, int n_in, void* d_out, int out_size, void* d_ws, size_t ws_size, hipStream_t stream) {
    static int grid = 0;
    if (grid == 0) {
        if (n_in != 26 || ws_size < mk::WS_END) { fprintf(stderr, "kernel_launch: unexpected n_in %d / ws %zu\n", n_in, ws_size); grid = -1; return; }
        int dev = 0, cus = 0, per_cu = 0;
        hipGetDevice(&dev); hipDeviceGetAttribute(&cus, hipDeviceAttributeMultiprocessorCount, dev);
        if (hipFuncSetAttribute((const void*)mk::fwd, hipFuncAttributeMaxDynamicSharedMemorySize, mk::LDS_BYTES) != hipSuccess) { fprintf(stderr, "kernel_launch: hipFuncSetAttribute failed\n"); grid = -1; return; }
        if (hipOccupancyMaxActiveBlocksPerMultiprocessor(&per_cu, (const void*)mk::fwd, mk::NT, mk::LDS_BYTES) != hipSuccess || per_cu < 1) { fprintf(stderr, "kernel_launch: occupancy query gives %d\n", per_cu); per_cu = 1; }
        (void)hipGetLastError();
        grid = cus * per_cu;
        if (grid > 256) grid = 256;
    }
    if (grid < 0) return;
    mk::Args a{};
    for (int i = 0; i < 26; ++i) a.in[i] = (const float*)d_in[i];
    a.out = (float*)d_out; a.ws = (unsigned char*)d_ws;
    void* kargs[] = {&a};
    hipError_t e = hipLaunchCooperativeKernel((const void*)mk::fwd, dim3(grid), dim3(mk::NT), kargs, mk::LDS_BYTES, stream);
    if (e != hipSuccess) fprintf(stderr, "cooperative launch failed: %s (grid %d)\n", hipGetErrorString(e), grid);
}
```

```cpp
#include <hip/hip_runtime.h>
#include <hip/hip_cooperative_groups.h>
#include <cstdio>
#include <cstdint>
namespace cg = cooperative_groups;
namespace pg8 {
#define PG8_LAS __attribute__((address_space(3)))
typedef unsigned short bf16_t;
typedef short bf16x8 __attribute__((ext_vector_type(8)));
typedef float f32x4 __attribute__((ext_vector_type(4)));
typedef unsigned u32x4 __attribute__((ext_vector_type(4)));
constexpr int BM = 256, BK = 64, HALF = 128, HTB = HALF * BK * 2  , STAGE_BYTES = 8 * HTB, NXCD = 8, WGM = 8;

__host__ __device__ __forceinline__ int lds_byte(int r, int c) { const int st = (r >> 4) * 2 + (c >> 5), rr = r & 15, cc = c & 31, ob = rr * 64 + cc * 2; return st * 1024 + (ob ^ (((ob >> 9) & 1) << 5)); }
__host__ __device__ __forceinline__ void stage_rc(int b, int& R, int& C) { const int st = b / 1024, sb = b % 1024, swz = sb ^ (((sb >> 9) & 1) << 5); R = (st >> 1) * 16 + swz / 64; C = (st & 1) * 32 + (swz % 64) / 2; }
__host__ __device__ __forceinline__ int perm32(int rho) { const int n = rho >> 4, i = rho & 15; return 8 * (i >> 2) + 4 * n + (i & 3); }

struct Unit { int pm, pn; };
struct Gemm { const bf16_t* A; const bf16_t* Bt; int M, N, K; };

struct StaticOrder {
    int nM, nN, nwg, G, c;
    __host__ __device__ void init(int M, int N, int G_, int c_) { nM = M / BM; nN = N / BM; nwg = nM * nN; G = G_; c = c_; }
    __host__ __device__ bool next(int i, Unit& u) const {
        const long L = (long)i * G + c; if (L >= nwg) return false;
        int wgid = (int)L; { const int q = nwg / NXCD, r = nwg % NXCD, xcd = wgid % NXCD, off = wgid / NXCD; wgid = (xcd < r ? xcd * (q + 1) : r * (q + 1) + (xcd - r) * q) + off; }
        const int nig = WGM * nN, gid = wgid / nig, fm = gid * WGM, gsz = (nM - fm) < WGM ? (nM - fm) : WGM;
        u.pm = fm + ((wgid % nig) % gsz); u.pn = (wgid % nig) / gsz; return true;
    }
    __device__ __forceinline__ void a_ready(const Unit&) const {}
    __device__ __forceinline__ void done(const Unit&) const {}
};

__device__ __forceinline__ unsigned cvt_pk_bf16(float lo, float hi) { unsigned r; asm volatile("v_cvt_pk_bf16_f32 %0, %1, %2" : "=v"(r) : "v"(lo), "v"(hi)); return r; }
typedef float f32x2 __attribute__((ext_vector_type(2)));
__device__ __forceinline__ f32x2 gelu_pk(f32x2 v) {
    const f32x2 av = __builtin_elementwise_abs(v), d = av * 0.2316418882f + 1.0f;
    f32x2 t; t.x = __builtin_amdgcn_rcpf(d.x); t.y = __builtin_amdgcn_rcpf(d.y);
    f32x2 q = t * 0.5307027145f + (-0.7265760135f); q = q * t + 0.7107068705f; q = q * t + (-0.142248368f); q = q * t + 0.127414796f; q = q * t;
    const f32x2 s = (v * v) * (-0.72134752044f);
    f32x2 e; e.x = __builtin_amdgcn_exp2f(s.x); e.y = __builtin_amdgcn_exp2f(s.y);
    const f32x2 m = v * (q * e), r = v - m;
    f32x2 o; o.x = v.x < 0.f ? m.x : r.x; o.y = v.y < 0.f ? m.y : r.y; return o;
}

template <int ACT  > struct EpiBf16 {
    static constexpr bool PERM = true, AFTER_DRAIN = false; static_assert(ACT == 0 || ACT == 1, "EpiBf16: ACT is 0 (none) or 1 (gelu_pk)");
    bf16_t* O; int ldc; const float* bias; int split_cols; size_t split_stride; float scale0;
    __device__ __forceinline__ void operator()(const f32x4 (&acc)[2][2][4][2], const Unit& u, int wr, int wc, int fr, int fq) const {
        const int row0 = u.pm * BM + wr * 64 + fr; int colt = u.pn * BM; bf16_t* base = O;
        float sc = 1.f; if (split_cols) { const int t = colt / split_cols; base += (size_t)t * split_stride; colt -= t * split_cols; if (t == 0) sc = scale0; }
        const int col0 = colt + wc * 32 + 8 * fq, bcol0 = u.pn * BM + wc * 32 + 8 * fq;
        f32x4 bv[2][2];
#pragma unroll
        for (int bj = 0; bj < 2; ++bj)
#pragma unroll
            for (int n = 0; n < 2; ++n) bv[bj][n] = bias ? *(const f32x4*)(bias + bcol0 + bj * HALF + 4 * n) : (f32x4){0.f, 0.f, 0.f, 0.f};
#pragma unroll
        for (int ai = 0; ai < 2; ++ai)
#pragma unroll
            for (int m = 0; m < 4; ++m) { bf16_t* rowp = base + (size_t)(row0 + ai * HALF + m * 16) * ldc + col0;
#pragma unroll
                for (int bj = 0; bj < 2; ++bj) { f32x4 v0 = acc[ai][bj][m][0] + bv[bj][0], v1 = acc[ai][bj][m][1] + bv[bj][1];
                    if (ACT == 1) { f32x2 a = gelu_pk((f32x2){v0[0], v0[1]}), b = gelu_pk((f32x2){v0[2], v0[3]}), c = gelu_pk((f32x2){v1[0], v1[1]}), d = gelu_pk((f32x2){v1[2], v1[3]});
                        v0 = (f32x4){a.x, a.y, b.x, b.y}; v1 = (f32x4){c.x, c.y, d.x, d.y}; }
                    v0 = v0 * sc; v1 = v1 * sc; u32x4 w; w.x = cvt_pk_bf16(v0[0], v0[1]); w.y = cvt_pk_bf16(v0[2], v0[3]); w.z = cvt_pk_bf16(v1[0], v1[1]); w.w = cvt_pk_bf16(v1[2], v1[3]);
                    *(u32x4*)(rowp + bj * HALF) = w; } }
    }
};
template <class Epi, class Sched, bool ALIGN_EPI = false, bool SP2 = false>
__device__ __forceinline__ void gemm_phase(PG8_LAS unsigned char* lds, const Gemm g, const Sched& S, const Epi& E) {
    const int tid = threadIdx.x, wid = __builtin_amdgcn_readfirstlane(tid >> 6), lane = tid & 63, wr = wid >> 2, wc = wid & 3, fr = lane & 15, fq = lane >> 4;
    const int K = g.K, nt = K / BK;
    unsigned voffA[2], voffB[2];
#pragma unroll
    for (int i = 0; i < 2; ++i) { int R, C; stage_rc(tid * 16 + i * 8192, R, C); const int Rb = Epi::PERM ? ((R & ~31) + perm32(R & 31)) : R;
        voffA[i] = (unsigned)(R * K + C) * 2u; voffB[i] = (unsigned)(Rb * K + C) * 2u; }
    const size_t kstep = (size_t)(BK * 2);
    const size_t hstep = (size_t)HALF * K * 2;
    const size_t tstep = 2 * hstep;
    const unsigned ldsw = (unsigned)wid * 1024u;
    const int aoff = lds_byte(wr * 64 + fr, fq * 8), boff = lds_byte(wc * 32 + fr, fq * 8);
#define PG8_SA(b, h) (((b) * 2 + (h)) * HTB)
#define PG8_SB(b, h) ((4 + (b) * 2 + (h)) * HTB)
#define PG8_STAGE(bufoff, gbase, voff) do { _Pragma("unroll") for (int _i = 0; _i < 2; ++_i) \
        __builtin_amdgcn_global_load_lds((const unsigned*)((const char*)(gbase) + (voff)[_i]), (PG8_LAS unsigned*)(lds + (bufoff) + ldsw + _i * 8192), 16, 0, 0); } while (0)
#define PG8_LDA(dst, b, h) do { _Pragma("unroll") for (int m = 0; m < 4; ++m) _Pragma("unroll") for (int k = 0; k < 2; ++k) dst[m][k] = *(const PG8_LAS bf16x8*)(lds + PG8_SA(b, h) + aoff + m * 2048 + k * 1024); } while (0)
#define PG8_LDB(dst, b, h) do { _Pragma("unroll") for (int n = 0; n < 2; ++n) _Pragma("unroll") for (int k = 0; k < 2; ++k) dst[n][k] = *(const PG8_LAS bf16x8*)(lds + PG8_SB(b, h) + boff + n * 2048 + k * 1024); } while (0)
#define PG8_MMA(ai, bj, At, Bt) do { __builtin_amdgcn_s_setprio(1); _Pragma("unroll") for (int m = 0; m < 4; ++m) _Pragma("unroll") for (int n = 0; n < 2; ++n) _Pragma("unroll") for (int k = 0; k < 2; ++k) \
        acc[ai][bj][m][n] = __builtin_amdgcn_mfma_f32_16x16x32_bf16(Bt[n][k], At[m][k], acc[ai][bj][m][n], 0, 0, 0); __builtin_amdgcn_s_setprio(0); } while (0)
#define PG8_WAIT_V(n) asm volatile("s_waitcnt vmcnt(" #n ")" ::: "memory")
#define PG8_WAIT_L(n) asm volatile("s_waitcnt lgkmcnt(" #n ")" ::: "memory")
#define PG8_BAR __builtin_amdgcn_s_barrier()
#define PG8_SCHED __builtin_amdgcn_sched_barrier(0)
    Unit cur, nxt; int ui = 0;
    if (!S.next(0, cur)) return;
    f32x4 acc[2][2][4][2];
#pragma unroll
    for (int a = 0; a < 2; ++a)
#pragma unroll
        for (int b = 0; b < 2; ++b)
#pragma unroll
            for (int m = 0; m < 4; ++m)
#pragma unroll
                for (int n = 0; n < 2; ++n) acc[a][b][m][n] = (f32x4){0.f, 0.f, 0.f, 0.f};
    bf16x8 At[4][2], B0[2][2], B1[2][2];
    const char* cA = (const char*)g.A + (size_t)cur.pm * tstep; const char* cB = (const char*)g.Bt + (size_t)cur.pn * tstep;
    S.a_ready(cur);
    if constexpr (SP2) {
        PG8_STAGE(PG8_SB(0, 0), cB, voffB); PG8_STAGE(PG8_SB(0, 1), cB + hstep, voffB); PG8_STAGE(PG8_SA(0, 0), cA, voffA); PG8_STAGE(PG8_SA(0, 1), cA + hstep, voffA);
        if (wr == 1) PG8_BAR;
        PG8_WAIT_V(2); PG8_BAR;
        PG8_STAGE(PG8_SB(1, 0), cB + kstep, voffB); PG8_STAGE(PG8_SA(1, 0), cA + kstep, voffA); PG8_STAGE(PG8_SB(1, 1), cB + hstep + kstep, voffB);
        PG8_WAIT_V(6); PG8_BAR;
    } else {
        PG8_STAGE(PG8_SB(0, 0), cB, voffB); PG8_STAGE(PG8_SA(0, 0), cA, voffA); PG8_STAGE(PG8_SB(0, 1), cB + hstep, voffB); PG8_STAGE(PG8_SA(0, 1), cA + hstep, voffA);
        if (wr == 1) PG8_BAR;
        PG8_WAIT_V(4); PG8_BAR;
        PG8_STAGE(PG8_SB(1, 0), cB + kstep, voffB); PG8_STAGE(PG8_SA(1, 0), cA + kstep, voffA); PG8_STAGE(PG8_SB(1, 1), cB + hstep + kstep, voffB);
        PG8_WAIT_V(6); PG8_BAR;
    }
    for (;;) {
        const bool has_next = S.next(ui + 1, nxt);
        const char* nA = has_next ? (const char*)g.A + (size_t)nxt.pm * tstep : cA; const char* nB = has_next ? (const char*)g.Bt + (size_t)nxt.pn * tstep : cB;
        for (int t = 0; t < nt; t += 2) {
            const bool last = (t == nt - 2);
            const char* a1 = cA + (size_t)(t + 1) * kstep;
            const char* a2 = last ? nA : cA + (size_t)(t + 2) * kstep; const char* b2 = last ? nB : cB + (size_t)(t + 2) * kstep;
            const char* a3 = a2 + kstep; const char* b3 = b2 + kstep;
            if (last && has_next) S.a_ready(nxt);
            if constexpr (SP2) {
            PG8_LDB(B0, 0, 0); PG8_LDB(B1, 0, 1); PG8_SCHED; PG8_LDA(At, 0, 0); PG8_STAGE(PG8_SA(1, 1), a1 + hstep, voffA);
            PG8_WAIT_V(8); PG8_WAIT_L(0); PG8_BAR; PG8_MMA(0, 0, At, B0); PG8_MMA(0, 1, At, B1); PG8_BAR; PG8_SCHED;
            PG8_LDA(At, 0, 1); PG8_STAGE(PG8_SB(0, 0), b2, voffB); PG8_STAGE(PG8_SB(0, 1), b2 + hstep, voffB); PG8_STAGE(PG8_SA(0, 0), a2, voffA);
            PG8_WAIT_V(8); PG8_WAIT_L(0); PG8_BAR; PG8_MMA(1, 0, At, B0); PG8_MMA(1, 1, At, B1); PG8_BAR; PG8_SCHED;
            PG8_LDB(B0, 1, 0); PG8_LDB(B1, 1, 1); PG8_SCHED; PG8_LDA(At, 1, 0); PG8_STAGE(PG8_SA(0, 1), a2 + hstep, voffA);
            PG8_WAIT_V(8); PG8_WAIT_L(0); PG8_BAR; PG8_MMA(0, 0, At, B0); PG8_MMA(0, 1, At, B1); PG8_BAR; PG8_SCHED;
            PG8_LDA(At, 1, 1); PG8_STAGE(PG8_SB(1, 0), b3, voffB); PG8_STAGE(PG8_SB(1, 1), b3 + hstep, voffB); PG8_STAGE(PG8_SA(1, 0), a3, voffA);
            PG8_WAIT_V(8); PG8_WAIT_L(0); PG8_BAR; PG8_MMA(1, 0, At, B0); PG8_MMA(1, 1, At, B1); PG8_BAR; PG8_SCHED;
            } else {
            PG8_LDB(B0, 0, 0); PG8_SCHED; PG8_LDA(At, 0, 0); PG8_STAGE(PG8_SA(1, 1), a1 + hstep, voffA);
            PG8_WAIT_L(8); PG8_BAR; PG8_WAIT_L(0); PG8_MMA(0, 0, At, B0); PG8_BAR; PG8_SCHED;
            PG8_LDB(B1, 0, 1); PG8_STAGE(PG8_SB(0, 0), b2, voffB);
            PG8_BAR; PG8_WAIT_L(0); PG8_MMA(0, 1, At, B1); PG8_BAR;
            PG8_LDA(At, 0, 1); PG8_STAGE(PG8_SA(0, 0), a2, voffA);
            PG8_BAR; PG8_WAIT_L(0); PG8_MMA(1, 0, At, B0); PG8_BAR; PG8_SCHED;
            PG8_STAGE(PG8_SB(0, 1), b2 + hstep, voffB);
            PG8_WAIT_V(6); PG8_BAR; PG8_MMA(1, 1, At, B1); PG8_BAR;
            PG8_LDB(B0, 1, 0); PG8_SCHED; PG8_LDA(At, 1, 0); PG8_STAGE(PG8_SA(0, 1), a2 + hstep, voffA);
            PG8_WAIT_L(8); PG8_BAR; PG8_WAIT_L(0); PG8_MMA(0, 0, At, B0); PG8_BAR; PG8_SCHED;
            PG8_LDB(B1, 1, 1); PG8_STAGE(PG8_SB(1, 0), b3, voffB);
            PG8_BAR; PG8_WAIT_L(0); PG8_MMA(0, 1, At, B1); PG8_BAR;
            PG8_LDA(At, 1, 1); PG8_STAGE(PG8_SA(1, 0), a3, voffA);
            PG8_BAR; PG8_WAIT_L(0); PG8_MMA(1, 0, At, B0); PG8_BAR; PG8_SCHED;
            PG8_STAGE(PG8_SB(1, 1), b3 + hstep, voffB);
            PG8_WAIT_V(6); PG8_BAR; PG8_MMA(1, 1, At, B1); PG8_BAR;
            }
        }
        if constexpr (ALIGN_EPI) { if (wr == 0) PG8_BAR; }
        if constexpr (!Epi::AFTER_DRAIN) { E(acc, cur, wr, wc, fr, fq); S.done(cur); }
        if (!has_next) break;
#pragma unroll
        for (int a = 0; a < 2; ++a)
#pragma unroll
            for (int b = 0; b < 2; ++b)
#pragma unroll
                for (int m = 0; m < 4; ++m)
#pragma unroll
                    for (int n = 0; n < 2; ++n) acc[a][b][m][n] = (f32x4){0.f, 0.f, 0.f, 0.f};
        cur = nxt; cA = nA; cB = nB; ++ui;
        if constexpr (ALIGN_EPI) { if (wr == 1) PG8_BAR; }
    }
    PG8_WAIT_V(0);
    if constexpr (!ALIGN_EPI) { if (wr == 0) PG8_BAR; }
    PG8_BAR;
    if constexpr (Epi::AFTER_DRAIN) { E.fused(acc, cur, wr, wc, fr, fq, lds, wid, lane); S.done(cur); }
#undef PG8_SA
#undef PG8_SB
#undef PG8_STAGE
#undef PG8_LDA
#undef PG8_LDB
#undef PG8_MMA
#undef PG8_WAIT_V
#undef PG8_WAIT_L
#undef PG8_BAR
#undef PG8_SCHED
}
}
namespace pg8 {
struct EpiResid {
    static constexpr bool PERM = false, AFTER_DRAIN = false;
    const float* base; float* out; bf16_t* hg; const float* g; float* rowss;
    __device__ __forceinline__ void operator()(const f32x4 (&acc)[2][2][4][2], const Unit& u, int wr, int wc, int fr, int fq) const {
        typedef unsigned u32x2v __attribute__((ext_vector_type(2)));
        const int col0 = u.pn * BM + wc * 32 + 4 * fq;
#pragma unroll
        for (int ai = 0; ai < 2; ++ai)
#pragma unroll
            for (int m = 0; m < 4; ++m) {
                const int row = u.pm * BM + ai * HALF + wr * 64 + m * 16 + fr; const size_t off = (size_t)row * 1024 + col0; float ss = 0.f;
#pragma unroll
                for (int bj = 0; bj < 2; ++bj)
#pragma unroll
                    for (int n = 0; n < 2; ++n) { const int c = bj * HALF + n * 16;
                        const f32x4 v = *(const f32x4*)(base + off + c) + acc[ai][bj][m][n];
                        *(f32x4*)(out + off + c) = v; ss += (v[0] * v[0] + v[1] * v[1]) + (v[2] * v[2] + v[3] * v[3]);
                        if (hg) { const f32x4 w = v * *(const f32x4*)(g + col0 + c); u32x2v p; p.x = cvt_pk_bf16(w[0], w[1]); p.y = cvt_pk_bf16(w[2], w[3]); *(u32x2v*)(hg + off + c) = p; } }
                ss += __shfl_xor(ss, 16); ss += __shfl_xor(ss, 32);
                if (fq == 0) atomicAdd(rowss + row, ss);
                asm volatile("" ::: "memory");
            }
    }
};
struct EpiScaleBf16 {
    static constexpr bool PERM = true, AFTER_DRAIN = false;
    bf16_t* O; const float* rowss; float mul, eps;
    __device__ __forceinline__ void operator()(const f32x4 (&acc)[2][2][4][2], const Unit& u, int wr, int wc, int fr, int fq) const {
        const int col0 = u.pn * BM + wc * 32 + 8 * fq;
#pragma unroll
        for (int ai = 0; ai < 2; ++ai)
#pragma unroll
            for (int m = 0; m < 4; ++m) {
                const int row = u.pm * BM + ai * HALF + wr * 64 + m * 16 + fr; const float rs = rsqrtf(rowss[row] * (1.f / 1024.f) + eps) * mul;
                bf16_t* rowp = O + (size_t)row * 1024 + col0;
#pragma unroll
                for (int bj = 0; bj < 2; ++bj) { const f32x4 v0 = acc[ai][bj][m][0] * rs, v1 = acc[ai][bj][m][1] * rs;
                    u32x4 w; w.x = cvt_pk_bf16(v0[0], v0[1]); w.y = cvt_pk_bf16(v0[2], v0[3]); w.z = cvt_pk_bf16(v1[0], v1[1]); w.w = cvt_pk_bf16(v1[2], v1[3]);
                    *(u32x4*)(rowp + bj * HALF) = w; }
            }
    }
};
}
namespace pg8 {
constexpr int T_WIN = 2, T_WK = 17, T_WV = 21, T_XN = 40, T_MN = 104;
struct P1Order {
    StaticOrder z; int G, c;
    __device__ void init(int G_, int c_) { z.init(16384, 3840, G_, c_); G = G_; c = c_; }
    __device__ bool next(int i, Unit& u) const {
        const int L = i * G + c;
        if (L < 960) { z.next(i, u); u.pm += T_XN; u.pn += T_WIN; return true; }
        int r = L - 960;
        if (r < 32) { u.pm = T_MN + (r & 7); u.pn = T_WK + (r >> 3); return true; }
        r -= 32;
        if (r < 32) { u.pm = T_WV + (r & 3); u.pn = T_MN + (r >> 2); return true; }
        return false;
    }
    __device__ __forceinline__ void a_ready(const Unit&) const {}
    __device__ __forceinline__ void done(const Unit&) const {}
};
struct EpiP1 {
    static constexpr bool PERM = true, AFTER_DRAIN = false;
    bf16_t *z, *kmat, *vT;
    __device__ __forceinline__ void operator()(const f32x4 (&acc)[2][2][4][2], const Unit& u, int wr, int wc, int fr, int fq) const {
        bf16_t* O; int ldc, rowb, colb;
        if (u.pm >= T_MN) { O = kmat; ldc = 1024; rowb = (u.pm - T_MN) * BM; colb = (u.pn - T_WK) * BM; }
        else if (u.pm >= T_XN) { O = z; ldc = 3840; rowb = (u.pm - T_XN) * BM; colb = (u.pn - T_WIN) * BM; }
        else { O = vT; ldc = 2048; rowb = (u.pm - T_WV) * BM; colb = (u.pn - T_MN) * BM; }
        const int row0 = rowb + wr * 64 + fr, col0 = colb + wc * 32 + 8 * fq;
#pragma unroll
        for (int ai = 0; ai < 2; ++ai)
#pragma unroll
            for (int m = 0; m < 4; ++m) { bf16_t* rowp = O + (size_t)(row0 + ai * HALF + m * 16) * ldc + col0;
#pragma unroll
                for (int bj = 0; bj < 2; ++bj) { const f32x4 v0 = acc[ai][bj][m][0], v1 = acc[ai][bj][m][1];
                    u32x4 w; w.x = cvt_pk_bf16(v0[0], v0[1]); w.y = cvt_pk_bf16(v0[2], v0[3]); w.z = cvt_pk_bf16(v1[0], v1[1]); w.w = cvt_pk_bf16(v1[2], v1[3]);
                    *(u32x4*)(rowp + bj * HALF) = w; } }
    }
};
}
namespace mk {
#define LAS __attribute__((address_space(3)))
typedef unsigned short bf16;
typedef float f32x4 __attribute__((ext_vector_type(4)));
typedef unsigned v4u __attribute__((ext_vector_type(4)));
constexpr int NB = 8, SEQ = 2048, DM = 1024, M = NB * SEQ, MEML = 256, MM = NB * MEML;
constexpr int CSGU = 1536, CIN = 3712, ZP = 3840, CH = 128;
constexpr float RMS_EPS = 1e-6f, LN_EPS = 1e-5f, GN_EPS = 64e-5f;
constexpr float QSCALE = 0.0625f * 1.4426950408889634f;
constexpr size_t MiB = 1u << 20;
constexpr int NWAVES = 8, NT = 512, LDS_BYTES = 147456;
constexpr size_t WS_ROWSS1 = 0, WS_ROWSS2 = 65536;
constexpr size_t WS_WIN = 1 * MiB, WS_WKV = WS_WIN + (size_t)ZP * DM * 2, WS_WOUT = WS_WKV + 4 * MiB, WS_WQ = WS_WOUT + 2 * MiB, WS_WO = WS_WQ + 2 * MiB;
static_assert(WS_WO + 2 * MiB <= 20 * MiB, "weights");
constexpr size_t WS_XN = 20 * MiB, WS_YMIX = 20 * MiB, WS_MN = 52 * MiB, WS_KV = 56 * MiB, WS_Z = 64 * MiB;
constexpr size_t WS_YSCAN = 64 * MiB, WS_HG = 96 * MiB, WS_Q = 128 * MiB, WS_O = 160 * MiB;
constexpr size_t WS_R = 184 * MiB, WS_K = 200 * MiB, WS_V = 216 * MiB, WS_KK = 232 * MiB, WS_END = 256 * MiB;

struct Args { const float* in[26]; float* out; unsigned char* ws; };

#define LDS_WAIT() asm volatile("s_waitcnt lgkmcnt(0)" ::: "memory")
__device__ __forceinline__ unsigned f2bf(float f) { unsigned u = __builtin_bit_cast(unsigned, f); return (u + 0x7fffu + ((u >> 16) & 1u)) >> 16; }
__device__ __forceinline__ unsigned pk2(float lo, float hi) { return f2bf(lo) | (f2bf(hi) << 16); }
__device__ __forceinline__ float bf2f(bf16 h) { return __uint_as_float(((unsigned)h) << 16); }
__device__ __forceinline__ float wave_sum(float v) {
#pragma unroll
    for (int o = 1; o < 64; o <<= 1) v += __shfl_xor(v, o);
    return v;
}
__device__ __forceinline__ float wave_max(float v) {
#pragma unroll
    for (int o = 1; o < 64; o <<= 1) v = fmaxf(v, __shfl_xor(v, o));
    return v;
}
__device__ __forceinline__ float gelu_exact(float x) { return 0.5f * x * (1.f + erff(x * 0.70710678118654752f)); }
__device__ __forceinline__ float silu(float x) { return x / (1.f + __expf(-x)); }
__device__ __forceinline__ float sigmoidf(float x) { return 1.f / (1.f + __expf(-x)); }

__device__ __forceinline__ void p0_transpose_item(const float* W, int K, int N, bf16* WT, LAS float* scr, int item, int lane) {
    const int nblk = N / 32, kb = item / nblk, nb = item % nblk, k0 = 64 * kb, n0 = 32 * nb;
#pragma unroll 8
    for (int i = 0; i < 32; ++i) { const int kk = 2 * i + (lane >> 5); scr[kk * 33 + (lane & 31)] = W[(size_t)(k0 + kk) * N + n0 + (lane & 31)]; }
    LDS_WAIT();
    const int c = lane & 7;
#pragma unroll
    for (int j = 0; j < 4; ++j) { const int n = (lane >> 3) + 8 * j; const LAS float* s = scr + (8 * c) * 33 + n;
        v4u o; o.x = pk2(s[0 * 33], s[1 * 33]); o.y = pk2(s[2 * 33], s[3 * 33]); o.z = pk2(s[4 * 33], s[5 * 33]); o.w = pk2(s[6 * 33], s[7 * 33]);
        *(v4u*)(WT + (size_t)(n0 + n) * K + k0 + 8 * c) = o; }
    LDS_WAIT();
}
__device__ __forceinline__ void rms_row_to_bf16(const float* xrow, const float* g, bf16* orow, int lane) {
    const f32x4* xr = (const f32x4*)xrow + lane; const f32x4* gr = (const f32x4*)g + lane;
    f32x4 v[4]; float s = 0.f;
#pragma unroll
    for (int j = 0; j < 4; ++j) { v[j] = xr[64 * j]; s += (v[j].x * v[j].x + v[j].y * v[j].y) + (v[j].z * v[j].z + v[j].w * v[j].w); }
    const float rs = rsqrtf(wave_sum(s) * (1.f / DM) + RMS_EPS);
    unsigned long long* o8 = (unsigned long long*)orow + lane;
#pragma unroll
    for (int j = 0; j < 4; ++j) { const f32x4 w = v[j] * rs * gr[64 * j]; o8[64 * j] = (unsigned long long)pk2(w.x, w.y) | ((unsigned long long)pk2(w.z, w.w) << 32); }
}
__device__ __forceinline__ float dpp_ror(float v, const int ctrl) { return v; }
template <int CTRL> __device__ __forceinline__ float dppf(float v) { return __builtin_bit_cast(float, __builtin_amdgcn_update_dpp(0, __builtin_bit_cast(int, v), CTRL, 0xf, 0xf, false)); }
__device__ __forceinline__ float row_allreduce(float v) {
    v += dppf<0x128>(v); v += dppf<0x124>(v); v += dppf<0x122>(v); v += dppf<0x121>(v); return v;
}
__device__ __forceinline__ float zmix(const bf16* z, int tok, int j, const float* mu) {
    const float zt = bf2f(z[(size_t)tok * ZP + CSGU + j]);
    const float zp = (tok & (SEQ - 1)) ? bf2f(z[(size_t)(tok - 1) * ZP + CSGU + j]) : 0.f;
    return zt + (zp - zt) * mu[j];
}

__global__ void __launch_bounds__(NT, 2) fwd(Args args) {
    extern __shared__ __attribute__((aligned(16))) unsigned char lds_raw[];
    LAS unsigned char* lds = (LAS unsigned char*)lds_raw;
    cg::grid_group grid = cg::this_grid();
    const int tid = threadIdx.x, lane = tid & 63, wave = __builtin_amdgcn_readfirstlane(tid >> 6);
    const int G = gridDim.x, bid = blockIdx.x, gw = bid * NWAVES + wave, NGW = G * NWAVES;
    unsigned char* ws = args.ws; float* out = args.out;
    const float* x = args.in[0]; const float* mem = args.in[1]; const float* ln_mix_g = args.in[2]; const float* w_in = args.in[3];
    const float* sgu_ln_g = args.in[4]; const float* sgu_ln_b = args.in[5]; const float* sgu_ws = args.in[6]; const float* sgu_bs = args.in[7];
    const float* sgu_out_g = args.in[8]; const float* rw_mu = args.in[9]; const float* rw_w0 = args.in[10]; const float* rw_w2 = args.in[11];
    const float* rw_a0 = args.in[12]; const float* rw_a2 = args.in[13]; const float* rw_k_k = args.in[14]; const float* rw_k_a = args.in[15];
    const float* rw_r_k = args.in[16]; const float* rw_gn_g = args.in[17]; const float* rw_gn_b = args.in[18]; const float* w_out = args.in[19];
    const float* ln_x_g = args.in[20]; const float* ln_mem_g = args.in[21]; const float* w_q = args.in[22]; const float* w_kv = args.in[23];
    const float* w_o = args.in[24]; const float* ln_f_g = args.in[25];
    float* rowss1 = (float*)(ws + WS_ROWSS1); float* rowss2 = (float*)(ws + WS_ROWSS2);
    bf16* WinT = (bf16*)(ws + WS_WIN); bf16* WkvT = (bf16*)(ws + WS_WKV); bf16* WoutT = (bf16*)(ws + WS_WOUT); bf16* WqT = (bf16*)(ws + WS_WQ); bf16* WoT = (bf16*)(ws + WS_WO);
    bf16* xn = (bf16*)(ws + WS_XN); bf16* ymix = (bf16*)(ws + WS_YMIX); bf16* mn = (bf16*)(ws + WS_MN); bf16* kmat = (bf16*)(ws + WS_KV); bf16* vT = (bf16*)(ws + WS_KV + 4 * MiB); bf16* z = (bf16*)(ws + WS_Z);
    float* yscan = (float*)(ws + WS_YSCAN); bf16* hg = (bf16*)(ws + WS_HG); bf16* q = (bf16*)(ws + WS_Q); bf16* o = (bf16*)(ws + WS_O);
    bf16* R = (bf16*)(ws + WS_R); bf16* Kk = (bf16*)(ws + WS_K); bf16* V = (bf16*)(ws + WS_V); bf16* KK = (bf16*)(ws + WS_KK);
    float* Wd = out; bf16* ICL = (bf16*)(out + (size_t)M * 512); bf16* Gt = ICL + (size_t)M * 512; float* vln = out;

#ifndef NO_P0
    {
        LAS float* scr = (LAS float*)(lds + wave * 16384);
        constexpr int I_IN = 16 * (CIN / 32), I_KV = 16 * 64, I_SQ = 16 * 32, NITEMS = I_IN + I_KV + 3 * I_SQ;
        for (int it = gw; it < NITEMS; it += NGW) {
            int r = it;
            if (r < I_IN) { p0_transpose_item(w_in, DM, CIN, WinT, scr, r, lane); continue; } r -= I_IN;
            if (r < I_KV) { p0_transpose_item(w_kv, DM, 2048, WkvT, scr, r, lane); continue; } r -= I_KV;
            if (r < I_SQ) { p0_transpose_item(w_out, DM, DM, WoutT, scr, r, lane); continue; } r -= I_SQ;
            if (r < I_SQ) { p0_transpose_item(w_q, DM, DM, WqT, scr, r, lane); continue; } r -= I_SQ;
            p0_transpose_item(w_o, DM, DM, WoT, scr, r, lane);
        }
        for (int i = bid * NT + tid; i < (ZP - CIN) * DM / 8; i += G * NT) ((v4u*)(WinT + (size_t)CIN * DM))[i] = (v4u){0u, 0u, 0u, 0u};
        for (int i = bid * NT + tid; i < M; i += G * NT) { rowss1[i] = 0.f; rowss2[i] = 0.f; }
        for (int m = gw; m < M; m += NGW) rms_row_to_bf16(x + (size_t)m * DM, ln_mix_g, xn + (size_t)m * DM, lane);
        for (int m = gw; m < MM; m += NGW) rms_row_to_bf16(mem + (size_t)m * DM, ln_mem_g, mn + (size_t)m * DM, lane);
    }
#endif
    grid.sync();
#ifndef NO_P1
    {
        static_assert(WS_WIN == pg8::T_WIN * 524288 && WS_WKV == pg8::T_WK * 524288 && WS_XN == pg8::T_XN * 524288 && WS_MN == pg8::T_MN * 524288, "tile indices");
        pg8::Gemm g{(const bf16*)ws, (const bf16*)ws, M, ZP, DM}; pg8::P1Order S; S.init(G, bid);
        pg8::EpiP1 E{z, kmat, vT};
        pg8::gemm_phase<pg8::EpiP1, pg8::P1Order, true, true>(lds, g, S, E);
    }
#endif
    grid.sync();
#ifndef NO_P2b
    {
        typedef short bf16x8 __attribute__((ext_vector_type(8)));
        typedef float f32x2 __attribute__((ext_vector_type(2)));
        constexpr int RS = 272, ST_OFF = 512 * RS;
        LAS float* st_mean = (LAS float*)(lds + ST_OFF); LAS float* st_rstd = st_mean + 128; LAS float* st_part = st_rstd + 128;
        const int t16 = lane & 15, quad = lane >> 4;
        for (int unit = bid; unit < 256; unit += G) {
            const int bc = unit >> 1, rh = unit & 1; const size_t tok0 = (size_t)bc * CH;
            __syncthreads();
            for (int i = 0; i < 16; ++i) {
                const int s_ = wave * 16 + i;
                const v4u raw = *(const v4u*)(z + (tok0 + s_) * ZP + 512 + lane * 8);
                float sm = 0.f, sq = 0.f;
#pragma unroll
                for (int e = 0; e < 4; ++e) { const unsigned w_ = raw[e]; const f32x2 gv = pg8::gelu_pk((f32x2){__uint_as_float(w_ << 16), __uint_as_float(w_ & 0xffff0000u)}); sm += gv.x + gv.y; sq += gv.x * gv.x + gv.y * gv.y; }
                sm = wave_sum(sm); sq = wave_sum(sq);
                const float mean = sm * (1.f / 512.f), var = fmaxf(sq * (1.f / 512.f) - mean * mean, 0.f);
                if (lane == 0) { st_mean[s_] = mean; st_rstd[s_] = rsqrtf(var + LN_EPS); }
            }
            __syncthreads();
            {
                const int f = tid; const float gg = sgu_ln_g[f], bb = sgu_ln_b[f];
                for (int sb = 0; sb < 16; ++sb) {
                    float val[8];
#pragma unroll
                    for (int j = 0; j < 8; ++j) val[j] = bf2f(z[(tok0 + sb * 8 + j) * ZP + 512 + f]);
                    v4u w_;
#pragma unroll
                    for (int j2 = 0; j2 < 4; ++j2) { const f32x2 gv = pg8::gelu_pk((f32x2){val[2 * j2], val[2 * j2 + 1]});
                        const float a0 = (gv.x - st_mean[sb * 8 + 2 * j2]) * st_rstd[sb * 8 + 2 * j2] * gg + bb, a1 = (gv.y - st_mean[sb * 8 + 2 * j2 + 1]) * st_rstd[sb * 8 + 2 * j2 + 1] * gg + bb;
                        w_[j2] = pk2(a0, a1); }
                    *(LAS v4u*)(lds + f * RS + sb * 16) = w_;
                }
            }
            __syncthreads();
            const int nb = wave & 3, mh = wave >> 2, T0 = rh * 64 + nb * 16, t = T0 + t16; const int kbmax = (T0 + 15) >> 5;
            f32x4 acc[4][4];
#pragma unroll
            for (int h = 0; h < 4; ++h) {
                bf16x8 bfr[4];
#pragma unroll
                for (int kb = 0; kb < 4; ++kb) {
                    const float* wp = sgu_ws + ((size_t)(h * CH + t)) * CH + kb * 32 + quad * 8;
                    const f32x4 w0 = *(const f32x4*)wp, w1 = *(const f32x4*)(wp + 4); const int s0 = kb * 32 + quad * 8;
                    v4u w_;
                    w_.x = pk2(s0 + 0 <= t ? w0[0] : 0.f, s0 + 1 <= t ? w0[1] : 0.f); w_.y = pk2(s0 + 2 <= t ? w0[2] : 0.f, s0 + 3 <= t ? w0[3] : 0.f);
                    w_.z = pk2(s0 + 4 <= t ? w1[0] : 0.f, s0 + 5 <= t ? w1[1] : 0.f); w_.w = pk2(s0 + 6 <= t ? w1[2] : 0.f, s0 + 7 <= t ? w1[3] : 0.f);
                    bfr[kb] = __builtin_bit_cast(bf16x8, w_);
                }
#pragma unroll
                for (int mb = 0; mb < 4; ++mb) {
                    f32x4 a_ = (f32x4){0.f, 0.f, 0.f, 0.f};
                    const LAS unsigned char* ap = lds + (h * 128 + mh * 64 + mb * 16 + t16) * RS + quad * 16;
#pragma unroll
                    for (int kb = 0; kb < 4; ++kb) if (kb <= kbmax) a_ = __builtin_amdgcn_mfma_f32_16x16x32_bf16(*(const LAS bf16x8*)(ap + kb * 64), bfr[kb], a_, 0, 0, 0);
                    acc[h][mb] = a_;
                }
            }
            const size_t tok = tok0 + t; const bf16* zr = z + tok * ZP;
            float ss = 0.f;
#pragma unroll
            for (int h = 0; h < 4; ++h) {
                const float bsv = sgu_bs[h * CH + t];
#pragma unroll
                for (int mb = 0; mb < 4; ++mb) {
                    const int f = h * 128 + mh * 64 + mb * 16 + quad * 4;
                    const unsigned long long ur = *(const unsigned long long*)(zr + f);
                    const unsigned lo = (unsigned)ur, hi = (unsigned)(ur >> 32);
                    const f32x2 g0 = pg8::gelu_pk((f32x2){__uint_as_float(lo << 16), __uint_as_float(lo & 0xffff0000u)}), g1 = pg8::gelu_pk((f32x2){__uint_as_float(hi << 16), __uint_as_float(hi & 0xffff0000u)});
                    f32x4 p_ = acc[h][mb] + bsv; p_[0] *= g0.x; p_[1] *= g0.y; p_[2] *= g1.x; p_[3] *= g1.y;
                    acc[h][mb] = p_; ss += (p_[0] * p_[0] + p_[1] * p_[1]) + (p_[2] * p_[2] + p_[3] * p_[3]);
                }
            }
            ss += __shfl_xor(ss, 16); ss += __shfl_xor(ss, 32);
            if (quad == 0) st_part[mh * 64 + nb * 16 + t16] = ss;
            __syncthreads();
            const float rs = rsqrtf((st_part[nb * 16 + t16] + st_part[64 + nb * 16 + t16]) * (1.f / 512.f) + RMS_EPS);
#pragma unroll
            for (int h = 0; h < 4; ++h)
#pragma unroll
                for (int mb = 0; mb < 4; ++mb) {
                    const int f = h * 128 + mh * 64 + mb * 16 + quad * 4;
                    const unsigned long long gr = *(const unsigned long long*)(zr + 1024 + f);
                    const unsigned lo = (unsigned)gr, hi = (unsigned)(gr >> 32);
                    const f32x4 og = *(const f32x4*)(sgu_out_g + f);
                    const f32x4 p_ = acc[h][mb] * rs * og;
                    const float y0 = p_[0] * silu(__uint_as_float(lo << 16)), y1 = p_[1] * silu(__uint_as_float(lo & 0xffff0000u)), y2 = p_[2] * silu(__uint_as_float(hi << 16)), y3 = p_[3] * silu(__uint_as_float(hi & 0xffff0000u));
                    *(unsigned long long*)(ymix + tok * DM + f) = (unsigned long long)pk2(y0, y1) | ((unsigned long long)pk2(y2, y3) << 32);
                }
        }
    }
#endif
#ifndef NO_P2c
    {
        LAS float* swd = (LAS float*)lds; LAS float* sad = swd + 64;
        for (int tok = bid; tok < M; tok += G) {
            const int c = tid;
            const float r = zmix(z, tok, c, rw_mu), k = zmix(z, tok, 512 + c, rw_mu), v = zmix(z, tok, 1024 + c, rw_mu), gt = zmix(z, tok, 1536 + c, rw_mu);
            __syncthreads();
            if (c < 64) swd[c] = tanhf(zmix(z, tok, 2048 + c, rw_mu));
            else if (c < 128) sad[c - 64] = zmix(z, tok, 2112 + (c - 64), rw_mu);
            __syncthreads();
            float lw = rw_w0[c], la = rw_a0[c];
#pragma unroll 4
            for (int j = 0; j < 64; ++j) { lw += swd[j] * rw_w2[j * 512 + c]; la += sad[j] * rw_a2[j * 512 + c]; }
            const float xx = -lw;
            const float sp = fmaxf(xx, 0.f) + log1pf(expf(-fabsf(xx)));
            const float decay = expf(-expf(-sp - 0.5f));
            const float ic = sigmoidf(la);
            float kk = k * rw_k_k[c];
            const float ss = wave_sum(kk * kk);
            kk *= rsqrtf(fmaxf(ss, 1e-24f));
            const float k2 = k * (1.f + (ic - 1.f) * rw_k_a[c]);
            const size_t oo = (size_t)tok * 512 + c;
            R[oo] = (bf16)f2bf(r); Kk[oo] = (bf16)f2bf(k2); V[oo] = (bf16)f2bf(v); KK[oo] = (bf16)f2bf(kk); Wd[oo] = decay; ICL[oo] = (bf16)f2bf(ic); Gt[oo] = (bf16)f2bf(silu(gt));
        }
    }
#endif
    grid.sync();
#ifndef NO_P3
    {
        constexpr int TS = 16;
        constexpr int VEC_B = TS * 64 * 4, BUFB = 5 * VEC_B + TS * 16 * 4;
        for (int unit = bid; unit < 256; unit += G) {
            const int bh = unit >> 2, rg = unit & 3, b = bh >> 3, h = bh & 7;
            const size_t tok0 = (size_t)b * SEQ;
            float S0 = 0.f, S1 = 0.f, S2 = 0.f, S3 = 0.f;
            const int kq = lane & 15, rw = lane >> 4;
            __syncthreads();
            for (int c = -1; c < SEQ / TS; ++c) {
                if (wave >= 4) {
                    if (c + 1 < SEQ / TS) {
                        LAS unsigned char* bufp = lds + ((c + 1) & 1) * BUFB;
#pragma unroll
                        for (int i = 0; i < 4; ++i) {
                            const int st = (wave - 4) * 4 + i; const size_t tok = tok0 + (size_t)(c + 1) * TS + st; const size_t oo = tok * 512 + h * 64 + lane;
                            const float kk = bf2f(KK[oo]), ic = bf2f(ICL[oo]);
                            LAS float* f = (LAS float*)bufp + st * 64 + lane;
                            f[0] = -kk; f[TS * 64] = Wd[oo]; f[2 * TS * 64] = kk * ic; f[3 * TS * 64] = bf2f(Kk[oo]); f[4 * TS * 64] = bf2f(R[oo]);
                            if (lane < 16) ((LAS float*)(bufp + 5 * VEC_B))[st * 16 + lane] = bf2f(V[tok * 512 + h * 64 + rg * 16 + lane]);
                        }
                    }
                } else if (c >= 0) {
                    LAS unsigned char* bufp = lds + (c & 1) * BUFB;
                    const LAS f32x4* pa = (const LAS f32x4*)bufp + kq;
                    const LAS float* pv = (const LAS float*)(bufp + 5 * VEC_B) + wave * 4 + rw;
                    float* yo = yscan + (tok0 + (size_t)c * TS) * 512 + h * 64 + rg * 16 + wave * 4 + rw;
#pragma unroll
                    for (int i = 0; i < TS; ++i) {
                        const f32x4 a4 = pa[i * 16], w4 = pa[(TS + i) * 16], b4 = pa[(2 * TS + i) * 16], k4 = pa[(3 * TS + i) * 16], r4 = pa[(4 * TS + i) * 16];
                        const float vv = pv[i * 16];
                        float dot = (S0 * a4.x + S1 * a4.y) + (S2 * a4.z + S3 * a4.w);
                        dot = row_allreduce(dot);
                        S0 = S0 * w4.x + (dot * b4.x + vv * k4.x); S1 = S1 * w4.y + (dot * b4.y + vv * k4.y);
                        S2 = S2 * w4.z + (dot * b4.z + vv * k4.z); S3 = S3 * w4.w + (dot * b4.w + vv * k4.w);
                        float y = (S0 * r4.x + S1 * r4.y) + (S2 * r4.z + S3 * r4.w);
                        y = row_allreduce(y);
                        if (kq == 0) yo[(size_t)i * 512] = y;
                    }
                }
                __syncthreads();
            }
        }
    }
#endif
    grid.sync();
#ifndef NO_P4
    for (int it = gw; it < M * 8; it += NGW) {
        const int tok = it >> 3, h = it & 7, c = h * 64 + lane; const size_t oo = (size_t)tok * 512 + c;
        const float y = yscan[oo];
        const float mean = wave_sum(y) * (1.f / 64.f); const float d = y - mean;
        const float var = wave_sum(d * d) * (1.f / 64.f);
        const float yn = d * rsqrtf(var + GN_EPS) * rw_gn_g[c] + rw_gn_b[c];
        const float bonus = wave_sum(bf2f(R[oo]) * bf2f(Kk[oo]) * rw_r_k[c]) * bf2f(V[oo]);
        ymix[(size_t)tok * DM + 512 + c] = (bf16)f2bf((yn + bonus) * bf2f(Gt[oo]));
    }
#endif
    grid.sync();
#ifndef NO_P5
    {
        pg8::Gemm g{ymix, WoutT, M, DM, DM}; pg8::StaticOrder S; S.init(M, DM, G, bid);
        pg8::EpiResid E{x, out, hg, ln_x_g, rowss1};
        pg8::gemm_phase<pg8::EpiResid, pg8::StaticOrder, false, true>(lds, g, S, E);
    }
#endif
    grid.sync();
#ifndef NO_P6
    {
        pg8::Gemm g{hg, WqT, M, DM, DM}; pg8::StaticOrder S; S.init(M, DM, G, bid);
        pg8::EpiScaleBf16 E{q, rowss1, QSCALE, RMS_EPS};
        pg8::gemm_phase<pg8::EpiScaleBf16, pg8::StaticOrder, false, true>(lds, g, S, E);
    }
#endif
    grid.sync();
#ifndef NO_P7
    {
        typedef short bf16x8 __attribute__((ext_vector_type(8)));
        typedef short s16x4 __attribute__((ext_vector_type(4)));
        constexpr int KROW = 528, VROW = 144, ABUF = 36864;
        const int q16 = lane & 15, quad = lane >> 4;
        for (int unit = bid; unit < 512; unit += G) {
            const int bhh = unit >> 4, qt = unit & 15, b = bhh >> 2, h = bhh & 3;
            const size_t tokq = (size_t)b * SEQ + qt * 128 + wave * 16 + q16;
            bf16x8 qf[8];
#pragma unroll
            for (int kb = 0; kb < 8; ++kb) qf[kb] = *(const bf16x8*)(q + tokq * DM + h * 256 + kb * 32 + quad * 8);
            f32x4 sacc[16], oacc[16];
#pragma unroll
            for (int i = 0; i < 16; ++i) { sacc[i] = (f32x4){0.f, 0.f, 0.f, 0.f}; oacc[i] = (f32x4){0.f, 0.f, 0.f, 0.f}; }
            bf16x8 pf[8];
            float lsum = 1.f;
            v4u pre[4];
#define ATT_GLOAD(i) do { _Pragma("unroll") for (int j_ = 0; j_ < 4; ++j_) { const int c_ = tid + 512 * j_; \
                if ((i) < 4) pre[j_] = *(const v4u*)(kmat + (size_t)(b * MEML + (i) * 64 + (c_ >> 5)) * DM + h * 256 + (c_ & 31) * 8); \
                else pre[j_] = *(const v4u*)(vT + (size_t)(h * 256 + (c_ >> 3)) * 2048 + b * MEML + ((i) - 4) * 64 + (c_ & 7) * 8); } } while (0)
#define ATT_LSTORE(i) do { LAS unsigned char* bp_ = lds + ((i) & 1) * ABUF; _Pragma("unroll") for (int j_ = 0; j_ < 4; ++j_) { const int c_ = tid + 512 * j_; \
                if ((i) < 4) *(LAS v4u*)(bp_ + (c_ >> 5) * KROW + (c_ & 31) * 16) = pre[j_]; \
                else *(LAS v4u*)(bp_ + (c_ >> 3) * VROW + (c_ & 7) * 16) = pre[j_]; } } while (0)
            __syncthreads();
            ATT_GLOAD(0); ATT_LSTORE(0);
            __syncthreads();
#pragma unroll
            for (int i = 0; i < 8; ++i) {
                if (i + 1 < 8) ATT_GLOAD(i + 1);
                const LAS unsigned char* bp = lds + (i & 1) * ABUF;
                if (i < 4) {
#pragma unroll
                    for (int mbl = 0; mbl < 4; ++mbl)
#pragma unroll
                        for (int kb = 0; kb < 8; ++kb) {
                            const bf16x8 a = *(const LAS bf16x8*)(bp + (mbl * 16 + q16) * KROW + kb * 64 + quad * 16);
                            sacc[i * 4 + mbl] = __builtin_amdgcn_mfma_f32_16x16x32_bf16(a, qf[kb], sacc[i * 4 + mbl], 0, 0, 0);
                        }
                    if (i == 3) {
                        float mx = -3.0e38f;
#pragma unroll
                        for (int t = 0; t < 16; ++t) mx = fmaxf(mx, fmaxf(fmaxf(sacc[t][0], sacc[t][1]), fmaxf(sacc[t][2], sacc[t][3])));
                        mx = fmaxf(mx, __shfl_xor(mx, 16)); mx = fmaxf(mx, __shfl_xor(mx, 32));
                        float sm = 0.f;
#pragma unroll
                        for (int t = 0; t < 16; ++t) {
#pragma unroll
                            for (int j = 0; j < 4; ++j) { const float e = exp2f(sacc[t][j] - mx); sacc[t][j] = e; sm += e; } }
                        sm += __shfl_xor(sm, 16); sm += __shfl_xor(sm, 32);
                        lsum = sm;
#pragma unroll
                        for (int kb = 0; kb < 8; ++kb) {
                            v4u w; w.x = pk2(sacc[2 * kb][0], sacc[2 * kb][1]); w.y = pk2(sacc[2 * kb][2], sacc[2 * kb][3]);
                            w.z = pk2(sacc[2 * kb + 1][0], sacc[2 * kb + 1][1]); w.w = pk2(sacc[2 * kb + 1][2], sacc[2 * kb + 1][3]);
                            pf[kb] = __builtin_bit_cast(bf16x8, w);
                        }
                    }
                } else {
#pragma unroll
                    for (int mb = 0; mb < 16; ++mb)
#pragma unroll
                        for (int kbl = 0; kbl < 2; ++kbl) {
                            const LAS unsigned char* ap = bp + (mb * 16 + q16) * VROW + (32 * kbl + 4 * quad) * 2;
                            const s16x4 lo = *(const LAS s16x4*)ap, hi = *(const LAS s16x4*)(ap + 32);
                            const bf16x8 a = __builtin_shufflevector(lo, hi, 0, 1, 2, 3, 4, 5, 6, 7);
                            oacc[mb] = __builtin_amdgcn_mfma_f32_16x16x32_bf16(a, pf[(i - 4) * 2 + kbl], oacc[mb], 0, 0, 0);
                        }
                }
                if (i + 1 < 8) ATT_LSTORE(i + 1);
                __syncthreads();
            }
#undef ATT_GLOAD
#undef ATT_LSTORE
            const float inv = 1.f / lsum;
#pragma unroll
            for (int mb = 0; mb < 16; ++mb) {
                const f32x4 v = oacc[mb] * inv;
                *(unsigned long long*)(o + tokq * DM + h * 256 + mb * 16 + quad * 4) = (unsigned long long)pk2(v[0], v[1]) | ((unsigned long long)pk2(v[2], v[3]) << 32);
            }
        }
    }
#endif
    grid.sync();
#ifndef NO_P8
    {
        pg8::Gemm g{o, WoT, M, DM, DM}; pg8::StaticOrder S; S.init(M, DM, G, bid);
        pg8::EpiResid E{out, out, nullptr, nullptr, rowss2};
        pg8::gemm_phase<pg8::EpiResid, pg8::StaticOrder, false, true>(lds, g, S, E);
    }
#endif
    grid.sync();
#ifndef NO_P9
    for (int m = gw; m < M; m += NGW) {
        const float rs = rsqrtf(rowss2[m] * (1.f / DM) + RMS_EPS);
        f32x4* xr = (f32x4*)(out + (size_t)m * DM) + lane; const f32x4* gr = (const f32x4*)ln_f_g + lane;
#pragma unroll
        for (int j = 0; j < 4; ++j) xr[64 * j] = xr[64 * j] * rs * gr[64 * j];
    }
#endif
}
}

extern "C" void kernel_launch(void* const* d_in, const int* in_sizes, int n_in, void* d_out, int out_size, void* d_ws, size_t ws_size, hipStream_t stream) {
    static int grid = 0;
    if (grid == 0) {
        if (n_in != 26 || ws_size < mk::WS_END) { fprintf(stderr, "kernel_launch: unexpected n_in %d / ws %zu\n", n_in, ws_size); grid = -1; return; }
        int dev = 0, cus = 0, per_cu = 0;
        hipGetDevice(&dev); hipDeviceGetAttribute(&cus, hipDeviceAttributeMultiprocessorCount, dev);
        if (hipFuncSetAttribute((const void*)mk::fwd, hipFuncAttributeMaxDynamicSharedMemorySize, mk::LDS_BYTES) != hipSuccess) { fprintf(stderr, "kernel_launch: hipFuncSetAttribute failed\n"); grid = -1; return; }
        if (hipOccupancyMaxActiveBlocksPerMultiprocessor(&per_cu, (const void*)mk::fwd, mk::NT, mk::LDS_BYTES) != hipSuccess || per_cu < 1) { fprintf(stderr, "kernel_launch: occupancy query gives %d\n", per_cu); per_cu = 1; }
        (void)hipGetLastError();
        grid = cus * per_cu;
        if (grid > 256) grid = 256;
    }
    if (grid < 0) return;
    mk::Args a{};
    for (int i = 0; i < 26; ++i) a.in[i] = (const float*)d_in[i];
    a.out = (float*)d_out; a.ws = (unsigned char*)d_ws;
    void* kargs[] = {&a};
    hipError_t e = hipLaunchCooperativeKernel((const void*)mk::fwd, dim3(grid), dim3(mk::NT), kargs, mk::LDS_BYTES, stream);
    if (e != hipSuccess) fprintf(stderr, "cooperative launch failed: %s (grid %d)\n", hipGetErrorString(e), grid);
}
```

```cpp
#include <hip/hip_runtime.h>
#include <hip/hip_cooperative_groups.h>
#include <cstdio>
#include <cstdint>
namespace cg = cooperative_groups;
namespace pg8 {
#define PG8_LAS __attribute__((address_space(3)))
typedef unsigned short bf16_t;
typedef short bf16x8 __attribute__((ext_vector_type(8)));
typedef float f32x4 __attribute__((ext_vector_type(4)));
typedef unsigned u32x4 __attribute__((ext_vector_type(4)));
constexpr int BM = 256, BK = 64, HALF = 128, HTB = HALF * BK * 2  , STAGE_BYTES = 8 * HTB, NXCD = 8, WGM = 8;

__host__ __device__ __forceinline__ int lds_byte(int r, int c) { const int st = (r >> 4) * 2 + (c >> 5), rr = r & 15, cc = c & 31, ob = rr * 64 + cc * 2; return st * 1024 + (ob ^ (((ob >> 9) & 1) << 5)); }
__host__ __device__ __forceinline__ void stage_rc(int b, int& R, int& C) { const int st = b / 1024, sb = b % 1024, swz = sb ^ (((sb >> 9) & 1) << 5); R = (st >> 1) * 16 + swz / 64; C = (st & 1) * 32 + (swz % 64) / 2; }
__host__ __device__ __forceinline__ int perm32(int rho) { const int n = rho >> 4, i = rho & 15; return 8 * (i >> 2) + 4 * n + (i & 3); }

struct Unit { int pm, pn; };
struct Gemm { const bf16_t* A; const bf16_t* Bt; int M, N, K; };

struct StaticOrder {
    int nM, nN, nwg, G, c;
    __host__ __device__ void init(int M, int N, int G_, int c_) { nM = M / BM; nN = N / BM; nwg = nM * nN; G = G_; c = c_; }
    __host__ __device__ bool next(int i, Unit& u) const {
        const long L = (long)i * G + c; if (L >= nwg) return false;
        int wgid = (int)L; { const int q = nwg / NXCD, r = nwg % NXCD, xcd = wgid % NXCD, off = wgid / NXCD; wgid = (xcd < r ? xcd * (q + 1) : r * (q + 1) + (xcd - r) * q) + off; }
        const int nig = WGM * nN, gid = wgid / nig, fm = gid * WGM, gsz = (nM - fm) < WGM ? (nM - fm) : WGM;
        u.pm = fm + ((wgid % nig) % gsz); u.pn = (wgid % nig) / gsz; return true;
    }
    __device__ __forceinline__ void a_ready(const Unit&) const {}
    __device__ __forceinline__ void done(const Unit&) const {}
};

__device__ __forceinline__ unsigned cvt_pk_bf16(float lo, float hi) { unsigned r; asm volatile("v_cvt_pk_bf16_f32 %0, %1, %2" : "=v"(r) : "v"(lo), "v"(hi)); return r; }
typedef float f32x2 __attribute__((ext_vector_type(2)));
__device__ __forceinline__ f32x2 gelu_pk(f32x2 v) {
    const f32x2 av = __builtin_elementwise_abs(v), d = av * 0.2316418882f + 1.0f;
    f32x2 t; t.x = __builtin_amdgcn_rcpf(d.x); t.y = __builtin_amdgcn_rcpf(d.y);
    f32x2 q = t * 0.5307027145f + (-0.7265760135f); q = q * t + 0.7107068705f; q = q * t + (-0.142248368f); q = q * t + 0.127414796f; q = q * t;
    const f32x2 s = (v * v) * (-0.72134752044f);
    f32x2 e; e.x = __builtin_amdgcn_exp2f(s.x); e.y = __builtin_amdgcn_exp2f(s.y);
    const f32x2 m = v * (q * e), r = v - m;
    f32x2 o; o.x = v.x < 0.f ? m.x : r.x; o.y = v.y < 0.f ? m.y : r.y; return o;
}

template <int ACT  > struct EpiBf16 {
    static constexpr bool PERM = true, AFTER_DRAIN = false; static_assert(ACT == 0 || ACT == 1, "EpiBf16: ACT is 0 (none) or 1 (gelu_pk)");
    bf16_t* O; int ldc; const float* bias; int split_cols; size_t split_stride; float scale0;
    __device__ __forceinline__ void operator()(const f32x4 (&acc)[2][2][4][2], const Unit& u, int wr, int wc, int fr, int fq) const {
        const int row0 = u.pm * BM + wr * 64 + fr; int colt = u.pn * BM; bf16_t* base = O;
        float sc = 1.f; if (split_cols) { const int t = colt / split_cols; base += (size_t)t * split_stride; colt -= t * split_cols; if (t == 0) sc = scale0; }
        const int col0 = colt + wc * 32 + 8 * fq, bcol0 = u.pn * BM + wc * 32 + 8 * fq;
        f32x4 bv[2][2];
#pragma unroll
        for (int bj = 0; bj < 2; ++bj)
#pragma unroll
            for (int n = 0; n < 2; ++n) bv[bj][n] = bias ? *(const f32x4*)(bias + bcol0 + bj * HALF + 4 * n) : (f32x4){0.f, 0.f, 0.f, 0.f};
#pragma unroll
        for (int ai = 0; ai < 2; ++ai)
#pragma unroll
            for (int m = 0; m < 4; ++m) { bf16_t* rowp = base + (size_t)(row0 + ai * HALF + m * 16) * ldc + col0;
#pragma unroll
                for (int bj = 0; bj < 2; ++bj) { f32x4 v0 = acc[ai][bj][m][0] + bv[bj][0], v1 = acc[ai][bj][m][1] + bv[bj][1];
                    if (ACT == 1) { f32x2 a = gelu_pk((f32x2){v0[0], v0[1]}), b = gelu_pk((f32x2){v0[2], v0[3]}), c = gelu_pk((f32x2){v1[0], v1[1]}), d = gelu_pk((f32x2){v1[2], v1[3]});
                        v0 = (f32x4){a.x, a.y, b.x, b.y}; v1 = (f32x4){c.x, c.y, d.x, d.y}; }
                    v0 = v0 * sc; v1 = v1 * sc; u32x4 w; w.x = cvt_pk_bf16(v0[0], v0[1]); w.y = cvt_pk_bf16(v0[2], v0[3]); w.z = cvt_pk_bf16(v1[0], v1[1]); w.w = cvt_pk_bf16(v1[2], v1[3]);
                    *(u32x4*)(rowp + bj * HALF) = w; } }
    }
};
template <class Epi, class Sched, bool ALIGN_EPI = false, bool SP2 = false>
__device__ __forceinline__ void gemm_phase(PG8_LAS unsigned char* lds, const Gemm g, const Sched& S, const Epi& E) {
    const int tid = threadIdx.x, wid = __builtin_amdgcn_readfirstlane(tid >> 6), lane = tid & 63, wr = wid >> 2, wc = wid & 3, fr = lane & 15, fq = lane >> 4;
    const int K = g.K, nt = K / BK;
    unsigned voffA[2], voffB[2];
#pragma unroll
    for (int i = 0; i < 2; ++i) { int R, C; stage_rc(tid * 16 + i * 8192, R, C); const int Rb = Epi::PERM ? ((R & ~31) + perm32(R & 31)) : R;
        voffA[i] = (unsigned)(R * K + C) * 2u; voffB[i] = (unsigned)(Rb * K + C) * 2u; }
    const size_t kstep = (size_t)(BK * 2);
    const size_t hstep = (size_t)HALF * K * 2;
    const size_t tstep = 2 * hstep;
    const unsigned ldsw = (unsigned)wid * 1024u;
    const int aoff = lds_byte(wr * 64 + fr, fq * 8), boff = lds_byte(wc * 32 + fr, fq * 8);
#define PG8_SA(b, h) (((b) * 2 + (h)) * HTB)
#define PG8_SB(b, h) ((4 + (b) * 2 + (h)) * HTB)
#define PG8_STAGE(bufoff, gbase, voff) do { _Pragma("unroll") for (int _i = 0; _i < 2; ++_i) \
        __builtin_amdgcn_global_load_lds((const unsigned*)((const char*)(gbase) + (voff)[_i]), (PG8_LAS unsigned*)(lds + (bufoff) + ldsw + _i * 8192), 16, 0, 0); } while (0)
#define PG8_LDA(dst, b, h) do { _Pragma("unroll") for (int m = 0; m < 4; ++m) _Pragma("unroll") for (int k = 0; k < 2; ++k) dst[m][k] = *(const PG8_LAS bf16x8*)(lds + PG8_SA(b, h) + aoff + m * 2048 + k * 1024); } while (0)
#define PG8_LDB(dst, b, h) do { _Pragma("unroll") for (int n = 0; n < 2; ++n) _Pragma("unroll") for (int k = 0; k < 2; ++k) dst[n][k] = *(const PG8_LAS bf16x8*)(lds + PG8_SB(b, h) + boff + n * 2048 + k * 1024); } while (0)
#define PG8_MMA(ai, bj, At, Bt) do { __builtin_amdgcn_s_setprio(1); _Pragma("unroll") for (int m = 0; m < 4; ++m) _Pragma("unroll") for (int n = 0; n < 2; ++n) _Pragma("unroll") for (int k = 0; k < 2; ++k) \
        acc[ai][bj][m][n] = __builtin_amdgcn_mfma_f32_16x16x32_bf16(Bt[n][k], At[m][k], acc[ai][bj][m][n], 0, 0, 0); __builtin_amdgcn_s_setprio(0); } while (0)
#define PG8_WAIT_V(n) asm volatile("s_waitcnt vmcnt(" #n ")" ::: "memory")
#define PG8_WAIT_L(n) asm volatile("s_waitcnt lgkmcnt(" #n ")" ::: "memory")
#define PG8_BAR __builtin_amdgcn_s_barrier()
#define PG8_SCHED __builtin_amdgcn_sched_barrier(0)
    Unit cur, nxt; int ui = 0;
    if (!S.next(0, cur)) return;
    f32x4 acc[2][2][4][2];
#pragma unroll
    for (int a = 0; a < 2; ++a)
#pragma unroll
        for (int b = 0; b < 2; ++b)
#pragma unroll
            for (int m = 0; m < 4; ++m)
#pragma unroll
                for (int n = 0; n < 2; ++n) acc[a][b][m][n] = (f32x4){0.f, 0.f, 0.f, 0.f};
    bf16x8 At[4][2], B0[2][2], B1[2][2];
    const char* cA = (const char*)g.A + (size_t)cur.pm * tstep; const char* cB = (const char*)g.Bt + (size_t)cur.pn * tstep;
    S.a_ready(cur);
    if constexpr (SP2) {
        PG8_STAGE(PG8_SB(0, 0), cB, voffB); PG8_STAGE(PG8_SB(0, 1), cB + hstep, voffB); PG8_STAGE(PG8_SA(0, 0), cA, voffA); PG8_STAGE(PG8_SA(0, 1), cA + hstep, voffA);
        if (wr == 1) PG8_BAR;
        PG8_WAIT_V(2); PG8_BAR;
        PG8_STAGE(PG8_SB(1, 0), cB + kstep, voffB); PG8_STAGE(PG8_SA(1, 0), cA + kstep, voffA); PG8_STAGE(PG8_SB(1, 1), cB + hstep + kstep, voffB);
        PG8_WAIT_V(6); PG8_BAR;
    } else {
        PG8_STAGE(PG8_SB(0, 0), cB, voffB); PG8_STAGE(PG8_SA(0, 0), cA, voffA); PG8_STAGE(PG8_SB(0, 1), cB + hstep, voffB); PG8_STAGE(PG8_SA(0, 1), cA + hstep, voffA);
        if (wr == 1) PG8_BAR;
        PG8_WAIT_V(4); PG8_BAR;
        PG8_STAGE(PG8_SB(1, 0), cB + kstep, voffB); PG8_STAGE(PG8_SA(1, 0), cA + kstep, voffA); PG8_STAGE(PG8_SB(1, 1), cB + hstep + kstep, voffB);
        PG8_WAIT_V(6); PG8_BAR;
    }
    for (;;) {
        const bool has_next = S.next(ui + 1, nxt);
        const char* nA = has_next ? (const char*)g.A + (size_t)nxt.pm * tstep : cA; const char* nB = has_next ? (const char*)g.Bt + (size_t)nxt.pn * tstep : cB;
        for (int t = 0; t < nt; t += 2) {
            const bool last = (t == nt - 2);
            const char* a1 = cA + (size_t)(t + 1) * kstep;
            const char* a2 = last ? nA : cA + (size_t)(t + 2) * kstep; const char* b2 = last ? nB : cB + (size_t)(t + 2) * kstep;
            const char* a3 = a2 + kstep; const char* b3 = b2 + kstep;
            if (last && has_next) S.a_ready(nxt);
            if constexpr (SP2) {
            PG8_LDB(B0, 0, 0); PG8_LDB(B1, 0, 1); PG8_SCHED; PG8_LDA(At, 0, 0); PG8_STAGE(PG8_SA(1, 1), a1 + hstep, voffA);
            PG8_WAIT_V(8); PG8_WAIT_L(0); PG8_BAR; PG8_MMA(0, 0, At, B0); PG8_MMA(0, 1, At, B1); PG8_BAR; PG8_SCHED;
            PG8_LDA(At, 0, 1); PG8_STAGE(PG8_SB(0, 0), b2, voffB); PG8_STAGE(PG8_SB(0, 1), b2 + hstep, voffB); PG8_STAGE(PG8_SA(0, 0), a2, voffA);
            PG8_WAIT_V(8); PG8_WAIT_L(0); PG8_BAR; PG8_MMA(1, 0, At, B0); PG8_MMA(1, 1, At, B1); PG8_BAR; PG8_SCHED;
            PG8_LDB(B0, 1, 0); PG8_LDB(B1, 1, 1); PG8_SCHED; PG8_LDA(At, 1, 0); PG8_STAGE(PG8_SA(0, 1), a2 + hstep, voffA);
            PG8_WAIT_V(8); PG8_WAIT_L(0); PG8_BAR; PG8_MMA(0, 0, At, B0); PG8_MMA(0, 1, At, B1); PG8_BAR; PG8_SCHED;
            PG8_LDA(At, 1, 1); PG8_STAGE(PG8_SB(1, 0), b3, voffB); PG8_STAGE(PG8_SB(1, 1), b3 + hstep, voffB); PG8_STAGE(PG8_SA(1, 0), a3, voffA);
            PG8_WAIT_V(8); PG8_WAIT_L(0); PG8_BAR; PG8_MMA(1, 0, At, B0); PG8_MMA(1, 1, At, B1); PG8_BAR; PG8_SCHED;
            } else {
            PG8_LDB(B0, 0, 0); PG8_SCHED; PG8_LDA(At, 0, 0); PG8_STAGE(PG8_SA(1, 1), a1 + hstep, voffA);
            PG8_WAIT_L(8); PG8_BAR; PG8_WAIT_L(0); PG8_MMA(0, 0, At, B0); PG8_BAR; PG8_SCHED;
            PG8_LDB(B1, 0, 1); PG8_STAGE(PG8_SB(0, 0), b2, voffB);
            PG8_BAR; PG8_WAIT_L(0); PG8_MMA(0, 1, At, B1); PG8_BAR;
            PG8_LDA(At, 0, 1); PG8_STAGE(PG8_SA(0, 0), a2, voffA);
            PG8_BAR; PG8_WAIT_L(0); PG8_MMA(1, 0, At, B0); PG8_BAR; PG8_SCHED;
            PG8_STAGE(PG8_SB(0, 1), b2 + hstep, voffB);
            PG8_WAIT_V(6); PG8_BAR; PG8_MMA(1, 1, At, B1); PG8_BAR;
            PG8_LDB(B0, 1, 0); PG8_SCHED; PG8_LDA(At, 1, 0); PG8_STAGE(PG8_SA(0, 1), a2 + hstep, voffA);
            PG8_WAIT_L(8); PG8_BAR; PG8_WAIT_L(0); PG8_MMA(0, 0, At, B0); PG8_BAR; PG8_SCHED;
            PG8_LDB(B1, 1, 1); PG8_STAGE(PG8_SB(1, 0), b3, voffB);
            PG8_BAR; PG8_WAIT_L(0); PG8_MMA(0, 1, At, B1); PG8_BAR;
            PG8_LDA(At, 1, 1); PG8_STAGE(PG8_SA(1, 0), a3, voffA);
            PG8_BAR; PG8_WAIT_L(0); PG8_MMA(1, 0, At, B0); PG8_BAR; PG8_SCHED;
            PG8_STAGE(PG8_SB(1, 1), b3 + hstep, voffB);
            PG8_WAIT_V(6); PG8_BAR; PG8_MMA(1, 1, At, B1); PG8_BAR;
            }
        }
        if constexpr (ALIGN_EPI) { if (wr == 0) PG8_BAR; }
        if constexpr (!Epi::AFTER_DRAIN) { E(acc, cur, wr, wc, fr, fq); S.done(cur); }
        if (!has_next) break;
#pragma unroll
        for (int a = 0; a < 2; ++a)
#pragma unroll
            for (int b = 0; b < 2; ++b)
#pragma unroll
                for (int m = 0; m < 4; ++m)
#pragma unroll
                    for (int n = 0; n < 2; ++n) acc[a][b][m][n] = (f32x4){0.f, 0.f, 0.f, 0.f};
        cur = nxt; cA = nA; cB = nB; ++ui;
        if constexpr (ALIGN_EPI) { if (wr == 1) PG8_BAR; }
    }
    PG8_WAIT_V(0);
    if constexpr (!ALIGN_EPI) { if (wr == 0) PG8_BAR; }
    PG8_BAR;
    if constexpr (Epi::AFTER_DRAIN) { E.fused(acc, cur, wr, wc, fr, fq, lds, wid, lane); S.done(cur); }
#undef PG8_SA
#undef PG8_SB
#undef PG8_STAGE
#undef PG8_LDA
#undef PG8_LDB
#undef PG8_MMA
#undef PG8_WAIT_V
#undef PG8_WAIT_L
#undef PG8_BAR
#undef PG8_SCHED
}
}
namespace pg8 {
struct EpiResid {
    static constexpr bool PERM = false, AFTER_DRAIN = false;
    const float* base; float* out; bf16_t* hg; const float* g; float* rowss;
    __device__ __forceinline__ void operator()(const f32x4 (&acc)[2][2][4][2], const Unit& u, int wr, int wc, int fr, int fq) const {
        typedef unsigned u32x2v __attribute__((ext_vector_type(2)));
        const int col0 = u.pn * BM + wc * 32 + 4 * fq;
#pragma unroll
        for (int ai = 0; ai < 2; ++ai)
#pragma unroll
            for (int m = 0; m < 4; ++m) {
                const int row = u.pm * BM + ai * HALF + wr * 64 + m * 16 + fr; const size_t off = (size_t)row * 1024 + col0; float ss = 0.f;
#pragma unroll
                for (int bj = 0; bj < 2; ++bj)
#pragma unroll
                    for (int n = 0; n < 2; ++n) { const int c = bj * HALF + n * 16;
                        const f32x4 v = *(const f32x4*)(base + off + c) + acc[ai][bj][m][n];
                        *(f32x4*)(out + off + c) = v; ss += (v[0] * v[0] + v[1] * v[1]) + (v[2] * v[2] + v[3] * v[3]);
                        if (hg) { const f32x4 w = v * *(const f32x4*)(g + col0 + c); u32x2v p; p.x = cvt_pk_bf16(w[0], w[1]); p.y = cvt_pk_bf16(w[2], w[3]); *(u32x2v*)(hg + off + c) = p; } }
                ss += __shfl_xor(ss, 16); ss += __shfl_xor(ss, 32);
                if (fq == 0) atomicAdd(rowss + row, ss);
                asm volatile("" ::: "memory");
            }
    }
};
struct EpiScaleBf16 {
    static constexpr bool PERM = true, AFTER_DRAIN = false;
    bf16_t* O; const float* rowss; float mul, eps;
    __device__ __forceinline__ void operator()(const f32x4 (&acc)[2][2][4][2], const Unit& u, int wr, int wc, int fr, int fq) const {
        const int col0 = u.pn * BM + wc * 32 + 8 * fq;
#pragma unroll
        for (int ai = 0; ai < 2; ++ai)
#pragma unroll
            for (int m = 0; m < 4; ++m) {
                const int row = u.pm * BM + ai * HALF + wr * 64 + m * 16 + fr; const float rs = rsqrtf(rowss[row] * (1.f / 1024.f) + eps) * mul;
                bf16_t* rowp = O + (size_t)row * 1024 + col0;
#pragma unroll
                for (int bj = 0; bj < 2; ++bj) { const f32x4 v0 = acc[ai][bj][m][0] * rs, v1 = acc[ai][bj][m][1] * rs;
                    u32x4 w; w.x = cvt_pk_bf16(v0[0], v0[1]); w.y = cvt_pk_bf16(v0[2], v0[3]); w.z = cvt_pk_bf16(v1[0], v1[1]); w.w = cvt_pk_bf16(v1[2], v1[3]);
                    *(u32x4*)(rowp + bj * HALF) = w; }
            }
    }
};
}
namespace pg8 {
constexpr int T_WIN = 2, T_WK = 17, T_WV = 21, T_XN = 40, T_MN = 104;
struct P1Order {
    StaticOrder z; int G, c;
    __device__ void init(int G_, int c_) { z.init(16384, 3840, G_, c_); G = G_; c = c_; }
    __device__ bool next(int i, Unit& u) const {
        const int L = i * G + c;
        if (L < 960) { z.next(i, u); u.pm += T_XN; u.pn += T_WIN; return true; }
        int r = L - 960;
        if (r < 32) { u.pm = T_MN + (r & 7); u.pn = T_WK + (r >> 3); return true; }
        r -= 32;
        if (r < 32) { u.pm = T_WV + (r & 3); u.pn = T_MN + (r >> 2); return true; }
        return false;
    }
    __device__ __forceinline__ void a_ready(const Unit&) const {}
    __device__ __forceinline__ void done(const Unit&) const {}
};
struct EpiP1 {
    static constexpr bool PERM = true, AFTER_DRAIN = false;
    bf16_t *z, *kmat, *vT;
    __device__ __forceinline__ void operator()(const f32x4 (&acc)[2][2][4][2], const Unit& u, int wr, int wc, int fr, int fq) const {
        bf16_t* O; int ldc, rowb, colb;
        if (u.pm >= T_MN) { O = kmat; ldc = 1024; rowb = (u.pm - T_MN) * BM; colb = (u.pn - T_WK) * BM; }
        else if (u.pm >= T_XN) { O = z; ldc = 3840; rowb = (u.pm - T_XN) * BM; colb = (u.pn - T_WIN) * BM; }
        else { O = vT; ldc = 2048; rowb = (u.pm - T_WV) * BM; colb = (u.pn - T_MN) * BM; }
        const int row0 = rowb + wr * 64 + fr, col0 = colb + wc * 32 + 8 * fq;
#pragma unroll
        for (int ai = 0; ai < 2; ++ai)
#pragma unroll
            for (int m = 0; m < 4; ++m) { bf16_t* rowp = O + (size_t)(row0 + ai * HALF + m * 16) * ldc + col0;
#pragma unroll
                for (int bj = 0; bj < 2; ++bj) { const f32x4 v0 = acc[ai][bj][m][0], v1 = acc[ai][bj][m][1];
                    u32x4 w; w.x = cvt_pk_bf16(v0[0], v0[1]); w.y = cvt_pk_bf16(v0[2], v0[3]); w.z = cvt_pk_bf16(v1[0], v1[1]); w.w = cvt_pk_bf16(v1[2], v1[3]);
                    *(u32x4*)(rowp + bj * HALF) = w; } }
    }
};
}
namespace mk {
#define LAS __attribute__((address_space(3)))
typedef unsigned short bf16;
typedef float f32x4 __attribute__((ext_vector_type(4)));
typedef unsigned v4u __attribute__((ext_vector_type(4)));
constexpr int NB = 8, SEQ = 2048, DM = 1024, M = NB * SEQ, MEML = 256, MM = NB * MEML;
constexpr int CSGU = 1536, CIN = 3712, ZP = 3840, CH = 128;
constexpr float RMS_EPS = 1e-6f, LN_EPS = 1e-5f, GN_EPS = 64e-5f;
constexpr float QSCALE = 0.0625f * 1.4426950408889634f;
constexpr size_t MiB = 1u << 20;
constexpr int NWAVES = 8, NT = 512, LDS_BYTES = 147456;
constexpr size_t WS_ROWSS1 = 0, WS_ROWSS2 = 65536, WS_BAR = 262144, BAR_BYTES = 16384;
constexpr size_t WS_WIN = 1 * MiB, WS_WKV = WS_WIN + (size_t)ZP * DM * 2, WS_WOUT = WS_WKV + 4 * MiB, WS_WQ = WS_WOUT + 2 * MiB, WS_WO = WS_WQ + 2 * MiB;
static_assert(WS_WO + 2 * MiB <= 20 * MiB, "weights");
constexpr size_t WS_XN = 20 * MiB, WS_YMIX = 20 * MiB, WS_MN = 52 * MiB, WS_KV = 56 * MiB, WS_Z = 64 * MiB;
constexpr size_t WS_YSCAN = 64 * MiB, WS_HG = 96 * MiB, WS_Q = 128 * MiB, WS_O = 160 * MiB;
constexpr size_t WS_R = 184 * MiB, WS_K = 200 * MiB, WS_V = 216 * MiB, WS_KK = 232 * MiB, WS_END = 256 * MiB;

#define XB_TMO      128
#define XB_XCNT(j)  (256  + 64 * (j))
#define XB_XSUB(j)  (1280 + 64 * (j))
#define XB_XGEN(j)  (2304 + 64 * (j))
#define XB_TOP      3328
#define XB_TOPGEN   3392
#define XCD_BAR_WORDS 3456
#define XB_SPIN_CAP (1u << 18)

__device__ __forceinline__ unsigned xb_ld(unsigned* p)              { return __hip_atomic_load(p, __ATOMIC_RELAXED, __HIP_MEMORY_SCOPE_AGENT); }
__device__ __forceinline__ unsigned xb_add(unsigned* p, unsigned v) { return __hip_atomic_fetch_add(p, v, __ATOMIC_RELAXED, __HIP_MEMORY_SCOPE_AGENT); }
__device__ __forceinline__ unsigned xb_xcc_id() { return (unsigned)__builtin_amdgcn_s_getreg((3 << 11) | 20) & 0xFu; }
#define XB_SPIN(cond, bar) do { unsigned _sp = 0; while (cond) { __builtin_amdgcn_s_sleep(1); \
    if ((++_sp & 255u) == 0u) { if (xb_ld(&(bar)[XB_TMO])) break; if (_sp > XB_SPIN_CAP) { atomicAdd(&(bar)[XB_TMO], 1u); break; } } } } while (0)

struct XcdBarrier {
    unsigned* bar; unsigned x;
    volatile LAS unsigned* st;
};

__device__ __forceinline__ XcdBarrier xcd_barrier_post(unsigned* bar, volatile LAS unsigned* st) {
    XcdBarrier b; b.bar = bar; b.x = xb_xcc_id(); b.st = st;
    if (threadIdx.x == 0) (void)xb_add(&bar[XB_XCNT(b.x)], 1u);
    return b;
}
__device__ __forceinline__ void xcd_barrier_complete(unsigned* bar, unsigned x, unsigned& nloc, unsigned& nx) {
    const unsigned G = gridDim.x * gridDim.y * gridDim.z;
    unsigned sum, cnt, mine, sp = 0u;
    for (;;) {
        sum = 0u; cnt = 0u; mine = 0u;
#pragma unroll
        for (unsigned j = 0; j < 16; ++j) { const unsigned c = xb_ld(&bar[XB_XCNT(j)]); sum += c; cnt += (c > 0u) ? 1u : 0u; mine = (j == x) ? c : mine; }
        if (sum == G) break;
        __builtin_amdgcn_s_sleep(1);
        if ((++sp & 255u) == 0u) { if (xb_ld(&bar[XB_TMO])) break; if (sp > XB_SPIN_CAP) { atomicAdd(&bar[XB_TMO], 1u); break; } }
    }
    nloc = mine > 0u ? mine : 1u; nx = cnt > 0u ? cnt : 1u;
}

__device__ __forceinline__ void xcd_barrier(const XcdBarrier& b) {
    asm volatile("s_waitcnt vmcnt(0)" ::: "memory");
    __syncthreads();
    if (threadIdx.x == 0) {
        unsigned* bar = b.bar;
        __builtin_amdgcn_s_waitcnt(0);
        unsigned nloc = b.st[0], nx = b.st[1];
        if (nloc == 0u) { xcd_barrier_complete(bar, b.x, nloc, nx); b.st[0] = nloc; b.st[1] = nx; }
        const unsigned old = xb_add(&bar[XB_XSUB(b.x)], 1u);
        const unsigned gen = old / nloc;
        if (old + 1u == (gen + 1u) * nloc) {
            __builtin_amdgcn_fence(__ATOMIC_RELEASE, "agent");
            asm volatile("s_waitcnt vmcnt(0)" ::: "memory");
            const unsigned og = xb_add(&bar[XB_TOP], 1u);
            const unsigned tg = og / nx;
            if (og + 1u == (tg + 1u) * nx) xb_add(&bar[XB_TOPGEN], 1u);
            else XB_SPIN(xb_ld(&bar[XB_TOPGEN]) == tg, bar);
            __builtin_amdgcn_fence(__ATOMIC_ACQUIRE, "agent");
            xb_add(&bar[XB_XGEN(b.x)], 1u);
            asm volatile("s_waitcnt vmcnt(0)" ::: "memory");
        } else {
            XB_SPIN(xb_ld(&bar[XB_XGEN(b.x)]) == gen, bar);
            __builtin_amdgcn_fence(__ATOMIC_ACQUIRE, "agent");
            asm volatile("s_waitcnt vmcnt(0)" ::: "memory");
        }
    }
    __syncthreads();
}

struct Args { const float* in[26]; float* out; unsigned char* ws; };

#define LDS_WAIT() asm volatile("s_waitcnt lgkmcnt(0)" ::: "memory")
__device__ __forceinline__ unsigned f2bf(float f) { unsigned u = __builtin_bit_cast(unsigned, f); return (u + 0x7fffu + ((u >> 16) & 1u)) >> 16; }
__device__ __forceinline__ unsigned pk2(float lo, float hi) { return f2bf(lo) | (f2bf(hi) << 16); }
__device__ __forceinline__ float bf2f(bf16 h) { return __uint_as_float(((unsigned)h) << 16); }
__device__ __forceinline__ float wave_sum(float v) {
#pragma unroll
    for (int o = 1; o < 64; o <<= 1) v += __shfl_xor(v, o);
    return v;
}
__device__ __forceinline__ float wave_max(float v) {
#pragma unroll
    for (int o = 1; o < 64; o <<= 1) v = fmaxf(v, __shfl_xor(v, o));
    return v;
}
__device__ __forceinline__ float gelu_exact(float x) { return 0.5f * x * (1.f + erff(x * 0.70710678118654752f)); }
__device__ __forceinline__ float silu(float x) { return x / (1.f + __expf(-x)); }
__device__ __forceinline__ float sigmoidf(float x) { return 1.f / (1.f + __expf(-x)); }

__device__ __forceinline__ void p0_transpose_item(const float* W, int K, int N, bf16* WT, LAS float* scr, int item, int lane) {
    const int nblk = N / 32, kb = item / nblk, nb = item % nblk, k0 = 64 * kb, n0 = 32 * nb;
#pragma unroll 8
    for (int i = 0; i < 32; ++i) { const int kk = 2 * i + (lane >> 5); scr[kk * 33 + (lane & 31)] = W[(size_t)(k0 + kk) * N + n0 + (lane & 31)]; }
    LDS_WAIT();
    const int c = lane & 7;
#pragma unroll
    for (int j = 0; j < 4; ++j) { const int n = (lane >> 3) + 8 * j; const LAS float* s = scr + (8 * c) * 33 + n;
        v4u o; o.x = pk2(s[0 * 33], s[1 * 33]); o.y = pk2(s[2 * 33], s[3 * 33]); o.z = pk2(s[4 * 33], s[5 * 33]); o.w = pk2(s[6 * 33], s[7 * 33]);
        *(v4u*)(WT + (size_t)(n0 + n) * K + k0 + 8 * c) = o; }
    LDS_WAIT();
}
__device__ __forceinline__ void rms_row_to_bf16(const float* xrow, const float* g, bf16* orow, int lane) {
    const f32x4* xr = (const f32x4*)xrow + lane; const f32x4* gr = (const f32x4*)g + lane;
    f32x4 v[4]; float s = 0.f;
#pragma unroll
    for (int j = 0; j < 4; ++j) { v[j] = xr[64 * j]; s += (v[j].x * v[j].x + v[j].y * v[j].y) + (v[j].z * v[j].z + v[j].w * v[j].w); }
    const float rs = rsqrtf(wave_sum(s) * (1.f / DM) + RMS_EPS);
    unsigned long long* o8 = (unsigned long long*)orow + lane;
#pragma unroll
    for (int j = 0; j < 4; ++j) { const f32x4 w = v[j] * rs * gr[64 * j]; o8[64 * j] = (unsigned long long)pk2(w.x, w.y) | ((unsigned long long)pk2(w.z, w.w) << 32); }
}
__device__ __forceinline__ float dpp_ror(float v, const int ctrl) { return v; }
template <int CTRL> __device__ __forceinline__ float dppf(float v) { return __builtin_bit_cast(float, __builtin_amdgcn_update_dpp(0, __builtin_bit_cast(int, v), CTRL, 0xf, 0xf, false)); }
__device__ __forceinline__ float row_allreduce(float v) {
    v += dppf<0x128>(v); v += dppf<0x124>(v); v += dppf<0x122>(v); v += dppf<0x121>(v); return v;
}
__device__ __forceinline__ float zmix(const bf16* z, int tok, int j, const float* mu) {
    const float zt = bf2f(z[(size_t)tok * ZP + CSGU + j]);
    const float zp = (tok & (SEQ - 1)) ? bf2f(z[(size_t)(tok - 1) * ZP + CSGU + j]) : 0.f;
    return zt + (zp - zt) * mu[j];
}

__global__ void __launch_bounds__(NT, 2) fwd(Args args) {
    extern __shared__ __attribute__((aligned(16))) unsigned char lds_raw[];
    LAS unsigned char* lds = (LAS unsigned char*)lds_raw;
    cg::grid_group grid = cg::this_grid();
    const int tid = threadIdx.x, lane = tid & 63, wave = __builtin_amdgcn_readfirstlane(tid >> 6);
    const int G = gridDim.x, bid = blockIdx.x, gw = bid * NWAVES + wave, NGW = G * NWAVES;
    unsigned char* ws = args.ws; float* out = args.out;
    volatile LAS unsigned* bst = (volatile LAS unsigned*)(lds + LDS_BYTES - 64);
    if (tid < 4) bst[tid] = 0u;
    __syncthreads();
    XcdBarrier xbar = xcd_barrier_post((unsigned*)(ws + WS_BAR), bst);
    const float* x = args.in[0]; const float* mem = args.in[1]; const float* ln_mix_g = args.in[2]; const float* w_in = args.in[3];
    const float* sgu_ln_g = args.in[4]; const float* sgu_ln_b = args.in[5]; const float* sgu_ws = args.in[6]; const float* sgu_bs = args.in[7];
    const float* sgu_out_g = args.in[8]; const float* rw_mu = args.in[9]; const float* rw_w0 = args.in[10]; const float* rw_w2 = args.in[11];
    const float* rw_a0 = args.in[12]; const float* rw_a2 = args.in[13]; const float* rw_k_k = args.in[14]; const float* rw_k_a = args.in[15];
    const float* rw_r_k = args.in[16]; const float* rw_gn_g = args.in[17]; const float* rw_gn_b = args.in[18]; const float* w_out = args.in[19];
    const float* ln_x_g = args.in[20]; const float* ln_mem_g = args.in[21]; const float* w_q = args.in[22]; const float* w_kv = args.in[23];
    const float* w_o = args.in[24]; const float* ln_f_g = args.in[25];
    float* rowss1 = (float*)(ws + WS_ROWSS1); float* rowss2 = (float*)(ws + WS_ROWSS2); bf16* w2T = (bf16*)(ws + 131072); bf16* a2T = (bf16*)(ws + 196608);
    bf16* WinT = (bf16*)(ws + WS_WIN); bf16* WkvT = (bf16*)(ws + WS_WKV); bf16* WoutT = (bf16*)(ws + WS_WOUT); bf16* WqT = (bf16*)(ws + WS_WQ); bf16* WoT = (bf16*)(ws + WS_WO);
    bf16* xn = (bf16*)(ws + WS_XN); bf16* ymix = (bf16*)(ws + WS_YMIX); bf16* mn = (bf16*)(ws + WS_MN); bf16* kmat = (bf16*)(ws + WS_KV); bf16* vT = (bf16*)(ws + WS_KV + 4 * MiB); bf16* z = (bf16*)(ws + WS_Z);
    float* yscan = (float*)(ws + WS_YSCAN); bf16* hg = (bf16*)(ws + WS_HG); bf16* q = (bf16*)(ws + WS_Q); bf16* o = (bf16*)(ws + WS_O);
    bf16* R = (bf16*)(ws + WS_R); bf16* Kk = (bf16*)(ws + WS_K); bf16* V = (bf16*)(ws + WS_V); bf16* KK = (bf16*)(ws + WS_KK);
    float* Wd = out; bf16* ICL = (bf16*)(out + (size_t)M * 512); bf16* Gt = ICL + (size_t)M * 512; float* vln = out;

#ifndef NO_P0
#ifndef REP_P0
#define REP_P0 1
#endif
    for (int rep_ = 0; rep_ < REP_P0; ++rep_)
    {
        LAS float* scr = (LAS float*)(lds + wave * 16384);
        constexpr int I_IN = 16 * (CIN / 32), I_KV = 16 * 64, I_SQ = 16 * 32, NITEMS = I_IN + I_KV + 3 * I_SQ;
        for (int it = gw; it < NITEMS; it += NGW) {
            int r = it;
            if (r < I_IN) { p0_transpose_item(w_in, DM, CIN, WinT, scr, r, lane); continue; } r -= I_IN;
            if (r < I_KV) { p0_transpose_item(w_kv, DM, 2048, WkvT, scr, r, lane); continue; } r -= I_KV;
            if (r < I_SQ) { p0_transpose_item(w_out, DM, DM, WoutT, scr, r, lane); continue; } r -= I_SQ;
            if (r < I_SQ) { p0_transpose_item(w_q, DM, DM, WqT, scr, r, lane); continue; } r -= I_SQ;
            p0_transpose_item(w_o, DM, DM, WoT, scr, r, lane);
        }
        for (int i = bid * NT + tid; i < (ZP - CIN) * DM / 8; i += G * NT) ((v4u*)(WinT + (size_t)CIN * DM))[i] = (v4u){0u, 0u, 0u, 0u};
        for (int i = bid * NT + tid; i < M; i += G * NT) { rowss1[i] = 0.f; rowss2[i] = 0.f; }
        for (int i = bid * NT + tid; i < 512 * 64; i += G * NT) { const int n = i >> 6, k = i & 63; w2T[i] = (bf16)f2bf(rw_w2[k * 512 + n]); a2T[i] = (bf16)f2bf(rw_a2[k * 512 + n]); }
        for (int m = gw; m < M; m += NGW) rms_row_to_bf16(x + (size_t)m * DM, ln_mix_g, xn + (size_t)m * DM, lane);
        for (int m = gw; m < MM; m += NGW) rms_row_to_bf16(mem + (size_t)m * DM, ln_mem_g, mn + (size_t)m * DM, lane);
    }
#endif
    grid.sync();
#ifndef NO_P1
#ifndef REP_P1
#define REP_P1 1
#endif
    for (int rep_ = 0; rep_ < REP_P1; ++rep_)
    {
        static_assert(WS_WIN == pg8::T_WIN * 524288 && WS_WKV == pg8::T_WK * 524288 && WS_XN == pg8::T_XN * 524288 && WS_MN == pg8::T_MN * 524288, "tile indices");
        pg8::Gemm g{(const bf16*)ws, (const bf16*)ws, M, ZP, DM}; pg8::P1Order S; S.init(G, bid);
        pg8::EpiP1 E{z, kmat, vT};
        pg8::gemm_phase<pg8::EpiP1, pg8::P1Order, true, true>(lds, g, S, E);
    }
#endif
    xcd_barrier(xbar);
#ifndef NO_P2b
#ifndef REP_P2b
#define REP_P2b 1
#endif
    for (int rep_ = 0; rep_ < REP_P2b; ++rep_)
    {
        typedef short bf16x8 __attribute__((ext_vector_type(8)));
        typedef float f32x2 __attribute__((ext_vector_type(2)));
        constexpr int RS = 272, ST_OFF = 512 * RS;
        LAS float* st_mean = (LAS float*)(lds + ST_OFF); LAS float* st_rstd = st_mean + 128; LAS float* st_part = st_rstd + 128;
        const int t16 = lane & 15, quad = lane >> 4;
        for (int unit = bid; unit < 256; unit += G) {
            const int bc = unit >> 1, rh = unit & 1; const size_t tok0 = (size_t)bc * CH;
            __syncthreads();
            for (int i = 0; i < 16; ++i) {
                const int s_ = wave * 16 + i;
                const v4u raw = *(const v4u*)(z + (tok0 + s_) * ZP + 512 + lane * 8);
                float sm = 0.f, sq = 0.f;
#pragma unroll
                for (int e = 0; e < 4; ++e) { const unsigned w_ = raw[e]; const f32x2 gv = pg8::gelu_pk((f32x2){__uint_as_float(w_ << 16), __uint_as_float(w_ & 0xffff0000u)}); sm += gv.x + gv.y; sq += gv.x * gv.x + gv.y * gv.y; }
                sm = wave_sum(sm); sq = wave_sum(sq);
                const float mean = sm * (1.f / 512.f), var = fmaxf(sq * (1.f / 512.f) - mean * mean, 0.f);
                if (lane == 0) { st_mean[s_] = mean; st_rstd[s_] = rsqrtf(var + LN_EPS); }
            }
            __syncthreads();
            {
                const int f = tid; const float gg = sgu_ln_g[f], bb = sgu_ln_b[f];
                for (int sb = 0; sb < 16; ++sb) {
                    float val[8];
#pragma unroll
                    for (int j = 0; j < 8; ++j) val[j] = bf2f(z[(tok0 + sb * 8 + j) * ZP + 512 + f]);
                    v4u w_;
#pragma unroll
                    for (int j2 = 0; j2 < 4; ++j2) { const f32x2 gv = pg8::gelu_pk((f32x2){val[2 * j2], val[2 * j2 + 1]});
                        const float a0 = (gv.x - st_mean[sb * 8 + 2 * j2]) * st_rstd[sb * 8 + 2 * j2] * gg + bb, a1 = (gv.y - st_mean[sb * 8 + 2 * j2 + 1]) * st_rstd[sb * 8 + 2 * j2 + 1] * gg + bb;
                        w_[j2] = pk2(a0, a1); }
                    *(LAS v4u*)(lds + f * RS + sb * 16) = w_;
                }
            }
            __syncthreads();
            const int nb = wave & 3, mh = wave >> 2, T0 = rh * 64 + nb * 16, t = T0 + t16; const int kbmax = (T0 + 15) >> 5;
            f32x4 acc[4][4];
#pragma unroll
            for (int h = 0; h < 4; ++h) {
                bf16x8 bfr[4];
#pragma unroll
                for (int kb = 0; kb < 4; ++kb) {
                    const float* wp = sgu_ws + ((size_t)(h * CH + t)) * CH + kb * 32 + quad * 8;
                    const f32x4 w0 = *(const f32x4*)wp, w1 = *(const f32x4*)(wp + 4); const int s0 = kb * 32 + quad * 8;
                    v4u w_;
                    w_.x = pk2(s0 + 0 <= t ? w0[0] : 0.f, s0 + 1 <= t ? w0[1] : 0.f); w_.y = pk2(s0 + 2 <= t ? w0[2] : 0.f, s0 + 3 <= t ? w0[3] : 0.f);
                    w_.z = pk2(s0 + 4 <= t ? w1[0] : 0.f, s0 + 5 <= t ? w1[1] : 0.f); w_.w = pk2(s0 + 6 <= t ? w1[2] : 0.f, s0 + 7 <= t ? w1[3] : 0.f);
                    bfr[kb] = __builtin_bit_cast(bf16x8, w_);
                }
#pragma unroll
                for (int mb = 0; mb < 4; ++mb) {
                    f32x4 a_ = (f32x4){0.f, 0.f, 0.f, 0.f};
                    const LAS unsigned char* ap = lds + (h * 128 + mh * 64 + mb * 16 + t16) * RS + quad * 16;
#pragma unroll
                    for (int kb = 0; kb < 4; ++kb) if (kb <= kbmax) a_ = __builtin_amdgcn_mfma_f32_16x16x32_bf16(*(const LAS bf16x8*)(ap + kb * 64), bfr[kb], a_, 0, 0, 0);
                    acc[h][mb] = a_;
                }
            }
            const size_t tok = tok0 + t; const bf16* zr = z + tok * ZP;
            float ss = 0.f;
#pragma unroll
            for (int h = 0; h < 4; ++h) {
                const float bsv = sgu_bs[h * CH + t];
#pragma unroll
                for (int mb = 0; mb < 4; ++mb) {
                    const int f = h * 128 + mh * 64 + mb * 16 + quad * 4;
                    const unsigned long long ur = *(const unsigned long long*)(zr + f);
                    const unsigned lo = (unsigned)ur, hi = (unsigned)(ur >> 32);
                    const f32x2 g0 = pg8::gelu_pk((f32x2){__uint_as_float(lo << 16), __uint_as_float(lo & 0xffff0000u)}), g1 = pg8::gelu_pk((f32x2){__uint_as_float(hi << 16), __uint_as_float(hi & 0xffff0000u)});
                    f32x4 p_ = acc[h][mb] + bsv; p_[0] *= g0.x; p_[1] *= g0.y; p_[2] *= g1.x; p_[3] *= g1.y;
                    acc[h][mb] = p_; ss += (p_[0] * p_[0] + p_[1] * p_[1]) + (p_[2] * p_[2] + p_[3] * p_[3]);
                }
            }
            ss += __shfl_xor(ss, 16); ss += __shfl_xor(ss, 32);
            if (quad == 0) st_part[mh * 64 + nb * 16 + t16] = ss;
            __syncthreads();
            const float rs = rsqrtf((st_part[nb * 16 + t16] + st_part[64 + nb * 16 + t16]) * (1.f / 512.f) + RMS_EPS);
#pragma unroll
            for (int h = 0; h < 4; ++h)
#pragma unroll
                for (int mb = 0; mb < 4; ++mb) {
                    const int f = h * 128 + mh * 64 + mb * 16 + quad * 4;
                    const unsigned long long gr = *(const unsigned long long*)(zr + 1024 + f);
                    const unsigned lo = (unsigned)gr, hi = (unsigned)(gr >> 32);
                    const f32x4 og = *(const f32x4*)(sgu_out_g + f);
                    const f32x4 p_ = acc[h][mb] * rs * og;
                    const float y0 = p_[0] * silu(__uint_as_float(lo << 16)), y1 = p_[1] * silu(__uint_as_float(lo & 0xffff0000u)), y2 = p_[2] * silu(__uint_as_float(hi << 16)), y3 = p_[3] * silu(__uint_as_float(hi & 0xffff0000u));
                    *(unsigned long long*)(ymix + tok * DM + f) = (unsigned long long)pk2(y0, y1) | ((unsigned long long)pk2(y2, y3) << 32);
                }
        }
    }
#endif
#ifndef NO_P2c
#ifndef REP_P2c
#define REP_P2c 1
#endif
    for (int rep_ = 0; rep_ < REP_P2c; ++rep_)
    {
        typedef short bf16x8 __attribute__((ext_vector_type(8)));
        const int t16 = lane & 15, quad = lane >> 4;
        for (int item = gw; item < 2048; item += NGW) {
            const int tile = item >> 1, hh = item & 1; const size_t tok = (size_t)tile * 16 + t16; const bool first = (tok & (SEQ - 1)) == 0;
            const bf16* zc = z + tok * ZP + CSGU; const bf16* zp = zc - ZP;
            bf16x8 bw[2], ba[2];
#pragma unroll
            for (int kb = 0; kb < 2; ++kb)
#pragma unroll
                for (int wh = 0; wh < 2; ++wh) {
                    const int col = 2048 + wh * 64 + kb * 32 + quad * 8;
                    const v4u cu = *(const v4u*)(zc + col); v4u pu = (v4u){0u, 0u, 0u, 0u}; if (!first) pu = *(const v4u*)(zp + col);
                    const f32x4 m0 = *(const f32x4*)(rw_mu + col), m1 = *(const f32x4*)(rw_mu + col + 4);
                    float v_[8];
#pragma unroll
                    for (int e = 0; e < 4; ++e) { const float c0 = __uint_as_float(cu[e] << 16), c1 = __uint_as_float(cu[e] & 0xffff0000u), p0 = __uint_as_float(pu[e] << 16), p1 = __uint_as_float(pu[e] & 0xffff0000u);
                        const float mu0 = e < 2 ? m0[2 * e] : m1[2 * e - 4], mu1 = e < 2 ? m0[2 * e + 1] : m1[2 * e - 3];
                        v_[2 * e] = c0 + (p0 - c0) * mu0; v_[2 * e + 1] = c1 + (p1 - c1) * mu1; }
                    v4u w_;
                    if (wh == 0) { w_.x = pk2(tanhf(v_[0]), tanhf(v_[1])); w_.y = pk2(tanhf(v_[2]), tanhf(v_[3])); w_.z = pk2(tanhf(v_[4]), tanhf(v_[5])); w_.w = pk2(tanhf(v_[6]), tanhf(v_[7])); bw[kb] = __builtin_bit_cast(bf16x8, w_); }
                    else { w_.x = pk2(v_[0], v_[1]); w_.y = pk2(v_[2], v_[3]); w_.z = pk2(v_[4], v_[5]); w_.w = pk2(v_[6], v_[7]); ba[kb] = __builtin_bit_cast(bf16x8, w_); }
                }
            for (int h4 = 0; h4 < 4; ++h4) {
                const int h = hh * 4 + h4;
                f32x4 lw[4], la[4];
#pragma unroll
                for (int mb = 0; mb < 4; ++mb) {
                    const int row = h * 64 + mb * 16 + t16;
                    f32x4 a_ = (f32x4){0.f, 0.f, 0.f, 0.f}, b_ = (f32x4){0.f, 0.f, 0.f, 0.f};
#pragma unroll
                    for (int kb = 0; kb < 2; ++kb) {
                        a_ = __builtin_amdgcn_mfma_f32_16x16x32_bf16(*(const bf16x8*)(w2T + row * 64 + kb * 32 + quad * 8), bw[kb], a_, 0, 0, 0);
                        b_ = __builtin_amdgcn_mfma_f32_16x16x32_bf16(*(const bf16x8*)(a2T + row * 64 + kb * 32 + quad * 8), ba[kb], b_, 0, 0, 0);
                    }
                    lw[mb] = a_; la[mb] = b_;
                }
                f32x4 kkv[4]; float ssk = 0.f;
#pragma unroll
                for (int mb = 0; mb < 4; ++mb) {
                    const int c = h * 64 + mb * 16 + quad * 4; const size_t oo = tok * 512 + c;
                    f32x4 mx[4];
#pragma unroll
                    for (int ar = 0; ar < 4; ++ar) {
                        const unsigned long long cu = *(const unsigned long long*)(zc + ar * 512 + c); unsigned long long pu = 0ull; if (!first) pu = *(const unsigned long long*)(zp + ar * 512 + c);
                        const f32x4 mu4 = *(const f32x4*)(rw_mu + ar * 512 + c);
                        const unsigned cl = (unsigned)cu, chi = (unsigned)(cu >> 32), pl = (unsigned)pu, phi = (unsigned)(pu >> 32);
                        const f32x4 cv = (f32x4){__uint_as_float(cl << 16), __uint_as_float(cl & 0xffff0000u), __uint_as_float(chi << 16), __uint_as_float(chi & 0xffff0000u)};
                        const f32x4 pv = (f32x4){__uint_as_float(pl << 16), __uint_as_float(pl & 0xffff0000u), __uint_as_float(phi << 16), __uint_as_float(phi & 0xffff0000u)};
                        mx[ar] = cv + (pv - cv) * mu4;
                    }
                    const f32x4 w0 = *(const f32x4*)(rw_w0 + c), a0 = *(const f32x4*)(rw_a0 + c), kk4 = *(const f32x4*)(rw_k_k + c), ka4 = *(const f32x4*)(rw_k_a + c);
                    f32x4 dec, icv, k2, sg;
#pragma unroll
                    for (int j = 0; j < 4; ++j) {
                        const float xx = -(lw[mb][j] + w0[j]);
                        const float sp = fmaxf(xx, 0.f) + __logf(1.f + __expf(-fabsf(xx)));
                        dec[j] = __expf(-__expf(-sp - 0.5f));
                        icv[j] = sigmoidf(la[mb][j] + a0[j]);
                        k2[j] = mx[1][j] * (1.f + (icv[j] - 1.f) * ka4[j]);
                        sg[j] = silu(mx[3][j]);
                    }
                    const f32x4 kq = mx[1] * kk4; kkv[mb] = kq; ssk += (kq[0] * kq[0] + kq[1] * kq[1]) + (kq[2] * kq[2] + kq[3] * kq[3]);
                    *(unsigned long long*)(R + oo) = (unsigned long long)pk2(mx[0][0], mx[0][1]) | ((unsigned long long)pk2(mx[0][2], mx[0][3]) << 32);
                    *(unsigned long long*)(Kk + oo) = (unsigned long long)pk2(k2[0], k2[1]) | ((unsigned long long)pk2(k2[2], k2[3]) << 32);
                    *(unsigned long long*)(V + oo) = (unsigned long long)pk2(mx[2][0], mx[2][1]) | ((unsigned long long)pk2(mx[2][2], mx[2][3]) << 32);
                    *(unsigned long long*)(ICL + oo) = (unsigned long long)pk2(icv[0], icv[1]) | ((unsigned long long)pk2(icv[2], icv[3]) << 32);
                    *(unsigned long long*)(Gt + oo) = (unsigned long long)pk2(sg[0], sg[1]) | ((unsigned long long)pk2(sg[2], sg[3]) << 32);
                    *(f32x4*)(Wd + oo) = dec;
                }
                ssk += __shfl_xor(ssk, 16); ssk += __shfl_xor(ssk, 32);
                const float rn = rsqrtf(fmaxf(ssk, 1e-24f));
#pragma unroll
                for (int mb = 0; mb < 4; ++mb) {
                    const size_t oo = tok * 512 + h * 64 + mb * 16 + quad * 4; const f32x4 kq = kkv[mb] * rn;
                    *(unsigned long long*)(KK + oo) = (unsigned long long)pk2(kq[0], kq[1]) | ((unsigned long long)pk2(kq[2], kq[3]) << 32);
                }
            }
        }
    }
#endif
    xcd_barrier(xbar);
#ifndef NO_P3
#ifndef REP_P3
#define REP_P3 1
#endif
    for (int rep_ = 0; rep_ < REP_P3; ++rep_)
    {
        typedef float f32x2 __attribute__((ext_vector_type(2)));
        constexpr int TS = 32, NCH = SEQ / TS;
        constexpr int VEC_B = TS * 64 * 4, BUFB = 5 * VEC_B + TS * 16 * 4;
        for (int unit = bid; unit < 256; unit += G) {
            const int bh = unit >> 2, rg = unit & 3, b = bh >> 3, h = bh & 7;
            const size_t tok0 = (size_t)b * SEQ;
            f32x2 S01 = (f32x2){0.f, 0.f}, S23 = (f32x2){0.f, 0.f};
            const int kq = lane & 15, rw = lane >> 4;
            float pkk[8], pic[8], pw[8], pk[8], pr[8], pv[8];
#define SCAN_GLOAD(cc) do { _Pragma("unroll") for (int i_ = 0; i_ < 8; ++i_) { const size_t tok_ = tok0 + (size_t)(cc) * TS + (wave - 4) * 8 + i_; const size_t oo_ = tok_ * 512 + h * 64 + lane; \
                pkk[i_] = bf2f(KK[oo_]); pic[i_] = bf2f(ICL[oo_]); pw[i_] = Wd[oo_]; pk[i_] = bf2f(Kk[oo_]); pr[i_] = bf2f(R[oo_]); pv[i_] = bf2f(V[tok_ * 512 + h * 64 + rg * 16 + (lane & 15)]); } } while (0)
#define SCAN_LSTORE(cc) do { LAS unsigned char* bp_ = lds + ((cc) & 1) * BUFB; _Pragma("unroll") for (int i_ = 0; i_ < 8; ++i_) { const int st_ = (wave - 4) * 8 + i_; LAS float* f_ = (LAS float*)bp_ + st_ * 64 + lane; \
                f_[0] = -pkk[i_]; f_[TS * 64] = pw[i_]; f_[2 * TS * 64] = pkk[i_] * pic[i_]; f_[3 * TS * 64] = pk[i_]; f_[4 * TS * 64] = pr[i_]; \
                if (lane < 16) ((LAS float*)(bp_ + 5 * VEC_B))[st_ * 16 + lane] = pv[i_]; } } while (0)
            __syncthreads();
            if (wave >= 4) { SCAN_GLOAD(0); SCAN_LSTORE(0); SCAN_GLOAD(1); }
            __syncthreads();
            for (int c = 0; c < NCH; ++c) {
                if (wave >= 4) {
                    if (c + 1 < NCH) { SCAN_LSTORE(c + 1); if (c + 2 < NCH) SCAN_GLOAD(c + 2); }
                } else {
                    const LAS unsigned char* bufp = lds + (c & 1) * BUFB;
                    const LAS f32x4* pa = (const LAS f32x4*)bufp + kq;
                    const LAS float* pvv = (const LAS float*)(bufp + 5 * VEC_B) + wave * 4 + rw;
                    float* yo = yscan + (tok0 + (size_t)c * TS) * 512 + h * 64 + rg * 16 + wave * 4 + rw;
#pragma unroll 8
                    for (int i = 0; i < TS; ++i) {
                        const f32x4 a4 = pa[i * 16], w4 = pa[(TS + i) * 16], b4 = pa[(2 * TS + i) * 16], k4 = pa[(3 * TS + i) * 16], r4 = pa[(4 * TS + i) * 16];
                        const float vv = pvv[i * 16];
                        const f32x2 d2 = S01 * (f32x2){a4.x, a4.y} + S23 * (f32x2){a4.z, a4.w};
                        const float dot = row_allreduce(d2.x + d2.y);
                        const f32x2 dd = (f32x2){dot, dot}, v2 = (f32x2){vv, vv};
                        S01 = S01 * (f32x2){w4.x, w4.y} + (dd * (f32x2){b4.x, b4.y} + v2 * (f32x2){k4.x, k4.y});
                        S23 = S23 * (f32x2){w4.z, w4.w} + (dd * (f32x2){b4.z, b4.w} + v2 * (f32x2){k4.z, k4.w});
                        const f32x2 y2 = S01 * (f32x2){r4.x, r4.y} + S23 * (f32x2){r4.z, r4.w};
                        const float y = row_allreduce(y2.x + y2.y);
                        if (kq == 0) yo[(size_t)i * 512] = y;
                    }
                }
                __syncthreads();
            }
#undef SCAN_GLOAD
#undef SCAN_LSTORE
        }
    }
#endif
    xcd_barrier(xbar);
#ifndef NO_P4
    for (int it = gw; it < M * 8 / 4; it += NGW) {
        const int pair = it * 4 + (lane >> 4), tok = pair >> 3, h = pair & 7, c = h * 64 + (lane & 15) * 4; const size_t oo = (size_t)tok * 512 + c;
        const f32x4 y = *(const f32x4*)(yscan + oo);
        const float mean = row_allreduce((y[0] + y[1]) + (y[2] + y[3])) * (1.f / 64.f); const f32x4 d = y - mean;
        const float var = row_allreduce((d[0] * d[0] + d[1] * d[1]) + (d[2] * d[2] + d[3] * d[3])) * (1.f / 64.f);
        const float rstd = rsqrtf(var + GN_EPS);
        const unsigned long long ru = *(const unsigned long long*)(R + oo), ku = *(const unsigned long long*)(Kk + oo), vu = *(const unsigned long long*)(V + oo), gu = *(const unsigned long long*)(Gt + oo);
#define UNPK4(u_) ((f32x4){__uint_as_float(((unsigned)(u_)) << 16), __uint_as_float(((unsigned)(u_)) & 0xffff0000u), __uint_as_float(((unsigned)((u_) >> 32)) << 16), __uint_as_float(((unsigned)((u_) >> 32)) & 0xffff0000u)})
        const f32x4 r4 = UNPK4(ru), k4 = UNPK4(ku), v4 = UNPK4(vu), g4 = UNPK4(gu);
#undef UNPK4
        const f32x4 rk = *(const f32x4*)(rw_r_k + c), gg = *(const f32x4*)(rw_gn_g + c), gb = *(const f32x4*)(rw_gn_b + c);
        const f32x4 t_ = r4 * k4 * rk;
        const float bonus = row_allreduce((t_[0] + t_[1]) + (t_[2] + t_[3]));
        const f32x4 o_ = (d * rstd * gg + gb + v4 * bonus) * g4;
        *(unsigned long long*)(ymix + (size_t)tok * DM + 512 + c) = (unsigned long long)pk2(o_[0], o_[1]) | ((unsigned long long)pk2(o_[2], o_[3]) << 32);
    }
#endif
    xcd_barrier(xbar);
#ifndef NO_P5
    {
        pg8::Gemm g{ymix, WoutT, M, DM, DM}; pg8::StaticOrder S; S.init(M, DM, G, bid);
        pg8::EpiResid E{x, out, hg, ln_x_g, rowss1};
        pg8::gemm_phase<pg8::EpiResid, pg8::StaticOrder, false, true>(lds, g, S, E);
    }
#endif
    xcd_barrier(xbar);
#ifndef NO_P6
    {
        pg8::Gemm g{hg, WqT, M, DM, DM}; pg8::StaticOrder S; S.init(M, DM, G, bid);
        pg8::EpiScaleBf16 E{q, rowss1, QSCALE, RMS_EPS};
        pg8::gemm_phase<pg8::EpiScaleBf16, pg8::StaticOrder, false, true>(lds, g, S, E);
    }
#endif
    xcd_barrier(xbar);
#ifndef NO_P7
#ifndef REP_P7
#define REP_P7 1
#endif
    for (int rep_ = 0; rep_ < REP_P7; ++rep_)
    {
        typedef short bf16x8 __attribute__((ext_vector_type(8)));
        typedef short s16x4 __attribute__((ext_vector_type(4)));
        constexpr int KROW = 528, VROW = 144, ABUF = 36864;
        const int q16 = lane & 15, quad = lane >> 4;
        for (int unit = bid; unit < 512; unit += G) {
            const int bhh = unit >> 4, qt = unit & 15, b = bhh >> 2, h = bhh & 3;
            const size_t tokq = (size_t)b * SEQ + qt * 128 + wave * 16 + q16;
            bf16x8 qf[8];
#pragma unroll
            for (int kb = 0; kb < 8; ++kb) qf[kb] = *(const bf16x8*)(q + tokq * DM + h * 256 + kb * 32 + quad * 8);
            f32x4 sacc[16], oacc[16];
#pragma unroll
            for (int i = 0; i < 16; ++i) { sacc[i] = (f32x4){0.f, 0.f, 0.f, 0.f}; oacc[i] = (f32x4){0.f, 0.f, 0.f, 0.f}; }
            bf16x8 pf[8];
            float lsum = 1.f;
            v4u pre[4];
#define ATT_GLOAD(i) do { _Pragma("unroll") for (int j_ = 0; j_ < 4; ++j_) { const int c_ = tid + 512 * j_; \
                if ((i) < 4) pre[j_] = *(const v4u*)(kmat + (size_t)(b * MEML + (i) * 64 + (c_ >> 5)) * DM + h * 256 + (c_ & 31) * 8); \
                else pre[j_] = *(const v4u*)(vT + (size_t)(h * 256 + (c_ >> 3)) * 2048 + b * MEML + ((i) - 4) * 64 + (c_ & 7) * 8); } } while (0)
#define ATT_LSTORE(i) do { LAS unsigned char* bp_ = lds + ((i) & 1) * ABUF; _Pragma("unroll") for (int j_ = 0; j_ < 4; ++j_) { const int c_ = tid + 512 * j_; \
                if ((i) < 4) *(LAS v4u*)(bp_ + (c_ >> 5) * KROW + (c_ & 31) * 16) = pre[j_]; \
                else *(LAS v4u*)(bp_ + (c_ >> 3) * VROW + (c_ & 7) * 16) = pre[j_]; } } while (0)
            __syncthreads();
            ATT_GLOAD(0); ATT_LSTORE(0);
            __syncthreads();
#pragma unroll
            for (int i = 0; i < 8; ++i) {
                if (i + 1 < 8) ATT_GLOAD(i + 1);
                const LAS unsigned char* bp = lds + (i & 1) * ABUF;
                if (i < 4) {
#pragma unroll
                    for (int mbl = 0; mbl < 4; ++mbl)
#pragma unroll
                        for (int kb = 0; kb < 8; ++kb) {
                            const bf16x8 a = *(const LAS bf16x8*)(bp + (mbl * 16 + q16) * KROW + kb * 64 + quad * 16);
                            sacc[i * 4 + mbl] = __builtin_amdgcn_mfma_f32_16x16x32_bf16(a, qf[kb], sacc[i * 4 + mbl], 0, 0, 0);
                        }
                    if (i == 3) {
                        float mx = -3.0e38f;
#pragma unroll
                        for (int t = 0; t < 16; ++t) mx = fmaxf(mx, fmaxf(fmaxf(sacc[t][0], sacc[t][1]), fmaxf(sacc[t][2], sacc[t][3])));
                        mx = fmaxf(mx, __shfl_xor(mx, 16)); mx = fmaxf(mx, __shfl_xor(mx, 32));
                        float sm = 0.f;
#pragma unroll
                        for (int t = 0; t < 16; ++t) {
#pragma unroll
                            for (int j = 0; j < 4; ++j) { const float e = exp2f(sacc[t][j] - mx); sacc[t][j] = e; sm += e; } }
                        sm += __shfl_xor(sm, 16); sm += __shfl_xor(sm, 32);
                        lsum = sm;
#pragma unroll
                        for (int kb = 0; kb < 8; ++kb) {
                            v4u w; w.x = pk2(sacc[2 * kb][0], sacc[2 * kb][1]); w.y = pk2(sacc[2 * kb][2], sacc[2 * kb][3]);
                            w.z = pk2(sacc[2 * kb + 1][0], sacc[2 * kb + 1][1]); w.w = pk2(sacc[2 * kb + 1][2], sacc[2 * kb + 1][3]);
                            pf[kb] = __builtin_bit_cast(bf16x8, w);
                        }
                    }
                } else {
#pragma unroll
                    for (int mb = 0; mb < 16; ++mb)
#pragma unroll
                        for (int kbl = 0; kbl < 2; ++kbl) {
                            const LAS unsigned char* ap = bp + (mb * 16 + q16) * VROW + (32 * kbl + 4 * quad) * 2;
                            const s16x4 lo = *(const LAS s16x4*)ap, hi = *(const LAS s16x4*)(ap + 32);
                            const bf16x8 a = __builtin_shufflevector(lo, hi, 0, 1, 2, 3, 4, 5, 6, 7);
                            oacc[mb] = __builtin_amdgcn_mfma_f32_16x16x32_bf16(a, pf[(i - 4) * 2 + kbl], oacc[mb], 0, 0, 0);
                        }
                }
                if (i + 1 < 8) ATT_LSTORE(i + 1);
                __syncthreads();
            }
#undef ATT_GLOAD
#undef ATT_LSTORE
            const float inv = 1.f / lsum;
#pragma unroll
            for (int mb = 0; mb < 16; ++mb) {
                const f32x4 v = oacc[mb] * inv;
                *(unsigned long long*)(o + tokq * DM + h * 256 + mb * 16 + quad * 4) = (unsigned long long)pk2(v[0], v[1]) | ((unsigned long long)pk2(v[2], v[3]) << 32);
            }
        }
    }
#endif
    xcd_barrier(xbar);
#ifndef NO_P8
    {
        pg8::Gemm g{o, WoT, M, DM, DM}; pg8::StaticOrder S; S.init(M, DM, G, bid);
        pg8::EpiResid E{out, out, nullptr, nullptr, rowss2};
        pg8::gemm_phase<pg8::EpiResid, pg8::StaticOrder, false, true>(lds, g, S, E);
    }
#endif
    xcd_barrier(xbar);
#ifndef NO_P9
    for (int m = gw; m < M; m += NGW) {
        const float rs = rsqrtf(rowss2[m] * (1.f / DM) + RMS_EPS);
        f32x4* xr = (f32x4*)(out + (size_t)m * DM) + lane; const f32x4* gr = (const f32x4*)ln_f_g + lane;
#pragma unroll
        for (int j = 0; j < 4; ++j) xr[64 * j] = xr[64 * j] * rs * gr[64 * j];
    }
#endif
}
}

extern "C" void kernel_launch(void* const* d_in, const int* in_sizes, int n_in, void* d_out, int out_size, void* d_ws, size_t ws_size, hipStream_t stream) {
    static int grid = 0;
    if (grid == 0) {
        if (n_in != 26 || ws_size < mk::WS_END) { fprintf(stderr, "kernel_launch: unexpected n_in %d / ws %zu\n", n_in, ws_size); grid = -1; return; }
        int dev = 0, cus = 0, per_cu = 0;
        hipGetDevice(&dev); hipDeviceGetAttribute(&cus, hipDeviceAttributeMultiprocessorCount, dev);
        if (hipFuncSetAttribute((const void*)mk::fwd, hipFuncAttributeMaxDynamicSharedMemorySize, mk::LDS_BYTES) != hipSuccess) { fprintf(stderr, "kernel_launch: hipFuncSetAttribute failed\n"); grid = -1; return; }
        if (hipOccupancyMaxActiveBlocksPerMultiprocessor(&per_cu, (const void*)mk::fwd, mk::NT, mk::LDS_BYTES) != hipSuccess || per_cu < 1) { fprintf(stderr, "kernel_launch: occupancy query gives %d\n", per_cu); per_cu = 1; }
        (void)hipGetLastError();
        grid = cus * per_cu;
        if (grid > 256) grid = 256;
    }
    if (grid < 0) return;
    mk::Args a{};
    for (int i = 0; i < 26; ++i) a.in[i] = (const float*)d_in[i];
    a.out = (float*)d_out; a.ws = (unsigned char*)d_ws;
    if (hipMemsetAsync((char*)d_ws + mk::WS_BAR, 0, mk::BAR_BYTES, stream) != hipSuccess) { fprintf(stderr, "memset failed\n"); return; }
    void* kargs[] = {&a};
    hipError_t e = hipLaunchCooperativeKernel((const void*)mk::fwd, dim3(grid), dim3(mk::NT), kargs, mk::LDS_BYTES, stream);
    if (e != hipSuccess) fprintf(stderr, "cooperative launch failed: %s (grid %d)\n", hipGetErrorString(e), grid);
}
```
